# Optimizing an MI355X kernel written in HIP

```python
import math
import jax, jax.numpy as jnp
from jax import lax
import numpy as np

D_MODEL = 1024
BATCH = 8
SEQ = 2048
DEPTH = 1

D_MIX = D_MODEL
DN_WIDTH = D_MIX // 2
DN_HEAD_K = 128
DN_HEAD_V = 128
DN_HEADS = DN_WIDTH // DN_HEAD_V
CONV_WIDTH = 4
CHUNK = 64
DF_WIDTH = D_MIX - DN_WIDTH
DF_HEAD_QK = 64
DF_HEAD_V = 2 * DF_HEAD_QK
DF_HEADS = DF_WIDTH // DF_HEAD_V
Q_BLOCK = 128
EPS = 1e-6

DN_QK = DN_HEADS * DN_HEAD_K
DN_V = DN_HEADS * DN_HEAD_V
DF_QK = DF_HEADS * 2 * DF_HEAD_QK
DF_V = DF_HEADS * DF_HEAD_V
COL_SIZES = (DN_QK, DN_QK, DN_V, DN_V, DN_HEADS, DN_HEADS, DF_QK, DF_QK, DF_V, DF_V)
IN_COLS = sum(COL_SIZES)
COL_OFFSETS = tuple(int(o) for o in np.cumsum(COL_SIZES)[:-1])

kernel_name = "hybrid_gdn_diffattn_parallel_heads"


def rmsnorm(x, gain):
    xf = x.astype(jnp.float32)
    y = xf * lax.rsqrt(jnp.mean(xf * xf, axis=-1, keepdims=True) + EPS)
    return (y * gain.astype(jnp.float32)).astype(x.dtype)


def l2norm(x):
    return x * lax.rsqrt(jnp.sum(x * x, axis=-1, keepdims=True) + EPS)


def causal_depthwise_conv(x, w):
    c = x.shape[-1]
    return lax.conv_general_dilated(
        x, w[:, None, :].astype(x.dtype), window_strides=(1,),
        padding=[(CONV_WIDTH - 1, 0)], dimension_numbers=("NWC", "WIO", "NWC"),
        feature_group_count=c)


def gated_delta_rule(q, k, v, g, beta):
    b, t, h, dk = q.shape
    dv = v.shape[-1]
    n = t // CHUNK

    def chunks(a):
        a = jnp.moveaxis(a, 2, 1)
        return a.reshape((b, h, n, CHUNK) + a.shape[3:])

    qc, kc, vc = chunks(q), chunks(k), chunks(v)
    gc = jnp.cumsum(chunks(g), axis=-1)
    bc = chunks(beta)
    k_beta = kc * bc[..., None]
    v_beta = vc * bc[..., None]

    tril = jnp.tril(jnp.ones((CHUNK, CHUNK), bool))
    strict = jnp.tril(jnp.ones((CHUNK, CHUNK), bool), -1)
    diff = gc[..., :, None] - gc[..., None, :]
    decay = jnp.exp(jnp.where(tril, diff, -jnp.inf))

    m = jnp.where(strict, jnp.einsum('bhncd,bhnsd->bhncs', k_beta, kc) * decay, 0.0)
    lmat = m + jnp.eye(CHUNK, dtype=m.dtype)
    rhs = jnp.concatenate([v_beta, k_beta * jnp.exp(gc)[..., None]], axis=-1)
    sol = lax.linalg.triangular_solve(lmat, rhs, left_side=True, lower=True,
                                      unit_diagonal=True)
    u, w = sol[..., :dv], sol[..., dv:]
    a_qk = jnp.einsum('bhncd,bhnsd->bhncs', qc, kc) * decay

    def step(state, inp):
        q_i, k_i, u_i, w_i, g_i, a_i = inp
        v_new = u_i - jnp.einsum('bhcd,bhdv->bhcv', w_i, state)
        o_i = (jnp.einsum('bhcd,bhdv->bhcv', q_i * jnp.exp(g_i)[..., None], state)
               + jnp.einsum('bhcs,bhsv->bhcv', a_i, v_new))
        g_last = g_i[..., -1]
        k_dec = k_i * jnp.exp(g_last[..., None] - g_i)[..., None]
        state = (state * jnp.exp(g_last)[..., None, None]
                 + jnp.einsum('bhcd,bhcv->bhdv', k_dec, v_new))
        return state, o_i

    xs = tuple(jnp.moveaxis(a, 2, 0) for a in (qc, kc, u, w, gc, a_qk))
    s0 = jnp.zeros((b, h, dk, dv), jnp.float32)
    _, o = lax.scan(step, s0, xs)
    o = jnp.transpose(o, (1, 0, 3, 2, 4))
    return o.reshape(b, t, h, dv)


def gated_deltanet_group(q, k, v, z, bb, aa, conv_w, a_log, dt_bias, out_gain):
    b, t, _ = q.shape
    qkv = jax.nn.silu(causal_depthwise_conv(jnp.concatenate([q, k, v], -1), conv_w))
    q, k, v = jnp.split(qkv, [DN_QK, 2 * DN_QK], axis=-1)
    q = l2norm(q.reshape(b, t, DN_HEADS, DN_HEAD_K).astype(jnp.float32)) * (DN_HEAD_K ** -0.5)
    k = l2norm(k.reshape(b, t, DN_HEADS, DN_HEAD_K).astype(jnp.float32))
    v = v.reshape(b, t, DN_HEADS, DN_HEAD_V).astype(jnp.float32)
    beta = jax.nn.sigmoid(bb.astype(jnp.float32))
    g = -jnp.exp(a_log.astype(jnp.float32)) * jax.nn.softplus(
        aa.astype(jnp.float32) + dt_bias.astype(jnp.float32))
    o = gated_delta_rule(q, k, v, g, beta)
    zf = z.reshape(b, t, DN_HEADS, DN_HEAD_V).astype(jnp.float32)
    o = rmsnorm(o, out_gain) * jax.nn.silu(zf)
    return o.reshape(b, t, DN_V).astype(z.dtype)


def diff_attention_group(q, k, v, z, q_gain, k_gain, lq1, lk1, lq2, lk2, out_gain, lambda_init):
    b, t, _ = q.shape
    q = rmsnorm(q.reshape(b, t, DF_HEADS, 2, DF_HEAD_QK), q_gain) * (DF_HEAD_QK ** -0.5)
    k = rmsnorm(k.reshape(b, t, DF_HEADS, 2, DF_HEAD_QK), k_gain)
    v = v.reshape(b, t, DF_HEADS, DF_HEAD_V)
    lam = (jnp.exp(jnp.sum(lq1.astype(jnp.float32) * lk1.astype(jnp.float32)))
           - jnp.exp(jnp.sum(lq2.astype(jnp.float32) * lk2.astype(jnp.float32)))
           + lambda_init)
    nb = t // Q_BLOCK
    qb = jnp.moveaxis(q.reshape(b, nb, Q_BLOCK, DF_HEADS, 2, DF_HEAD_QK), 1, 0)
    starts = jnp.arange(nb, dtype=jnp.int32) * Q_BLOCK
    key_pos = jnp.arange(t, dtype=jnp.int32)
    neg = jnp.finfo(jnp.float32).min

    def block(args):
        q_blk, start = args
        s = jnp.einsum('bqhcd,bkhcd->bhcqk', q_blk, k).astype(jnp.float32)
        q_pos = start + jnp.arange(Q_BLOCK, dtype=jnp.int32)
        mask = key_pos[None, :] <= q_pos[:, None]
        p = jax.nn.softmax(jnp.where(mask, s, neg), axis=-1)
        wts = p[:, :, 0] - lam * p[:, :, 1]
        return jnp.einsum('bhqk,bkhv->bqhv', wts.astype(v.dtype), v)

    o = lax.map(block, (qb, starts))
    o = jnp.moveaxis(o, 0, 1).reshape(b, t, DF_HEADS, DF_HEAD_V)
    o = rmsnorm(o, out_gain).astype(jnp.float32) * (1.0 - lambda_init)
    zf = z.reshape(b, t, DF_HEADS, DF_HEAD_V).astype(jnp.float32)
    o = o * jax.nn.silu(zf)
    return o.reshape(b, t, DF_V).astype(z.dtype)


def setup_inputs(seed: int = 0) -> dict:
    key = jax.random.key(seed)
    ks = jax.random.split(key, 16)
    f32 = jnp.float32
    x = jax.random.normal(ks[0], (BATCH, SEQ, D_MODEL), f32)
    norm_gain = 1.0 + 0.05 * jax.random.normal(ks[1], (DEPTH, D_MODEL), f32)
    w_in = jax.random.normal(ks[2], (DEPTH, D_MODEL, IN_COLS), f32) * D_MODEL ** -0.5
    conv_w = jax.random.normal(ks[3], (DEPTH, CONV_WIDTH, DN_QK * 2 + DN_V), f32) * CONV_WIDTH ** -0.5
    a_log = jnp.log(jax.random.uniform(ks[4], (DEPTH, DN_HEADS), f32, 1.0, 16.0))
    dt = jnp.exp(jax.random.uniform(ks[5], (DEPTH, DN_HEADS), f32,
                                    math.log(1e-3), math.log(1e-1)))
    dt_bias = dt + jnp.log(-jnp.expm1(-dt))
    dn_out_gain = 1.0 + 0.05 * jax.random.normal(ks[6], (DEPTH, DN_HEAD_V), f32)
    q_gain = 1.0 + 0.05 * jax.random.normal(ks[7], (DEPTH, DF_HEAD_QK), f32)
    k_gain = 1.0 + 0.05 * jax.random.normal(ks[8], (DEPTH, DF_HEAD_QK), f32)
    lambda_q1 = 0.1 * jax.random.normal(ks[9], (DEPTH, DF_HEAD_QK), f32)
    lambda_k1 = 0.1 * jax.random.normal(ks[10], (DEPTH, DF_HEAD_QK), f32)
    lambda_q2 = 0.1 * jax.random.normal(ks[11], (DEPTH, DF_HEAD_QK), f32)
    lambda_k2 = 0.1 * jax.random.normal(ks[12], (DEPTH, DF_HEAD_QK), f32)
    df_out_gain = 1.0 + 0.05 * jax.random.normal(ks[13], (DEPTH, DF_HEAD_V), f32)
    w_out = jax.random.normal(ks[14], (DEPTH, D_MIX, D_MODEL), f32) * D_MIX ** -0.5
    return {"x": x, "norm_gain": norm_gain, "w_in": w_in, "conv_w": conv_w,
            "a_log": a_log, "dt_bias": dt_bias, "dn_out_gain": dn_out_gain,
            "q_gain": q_gain, "k_gain": k_gain, "lambda_q1": lambda_q1,
            "lambda_k1": lambda_k1, "lambda_q2": lambda_q2, "lambda_k2": lambda_k2,
            "df_out_gain": df_out_gain, "w_out": w_out}


def reference(x, norm_gain, w_in, conv_w, a_log, dt_bias, dn_out_gain, q_gain, k_gain,
              lambda_q1, lambda_k1, lambda_q2, lambda_k2, df_out_gain, w_out):
    for l in range(DEPTH):
        lambda_init = 0.8 - 0.6 * math.exp(-0.3 * l)
        h = rmsnorm(x, norm_gain[l])
        proj = jnp.einsum('btd,dc->btc', h, w_in[l])
        (dn_q, dn_k, dn_v, dn_z, dn_b, dn_a,
         df_q, df_k, df_v, df_z) = jnp.split(proj, COL_OFFSETS, axis=-1)
        o_dn = gated_deltanet_group(dn_q, dn_k, dn_v, dn_z, dn_b, dn_a, conv_w[l],
                                    a_log[l], dt_bias[l], dn_out_gain[l])
        o_df = diff_attention_group(df_q, df_k, df_v, df_z, q_gain[l], k_gain[l],
                                    lambda_q1[l], lambda_k1[l], lambda_q2[l], lambda_k2[l],
                                    df_out_gain[l], lambda_init)
        mixed = jnp.concatenate([o_dn, o_df], axis=-1)
        x = x + jnp.einsum('btc,cd->btd', mixed, w_out[l])
    return x
```

```cpp
#include <hip/hip_runtime.h>
#include <hip/hip_cooperative_groups.h>
#include <cstdio>
#include <cstdint>
namespace cg = cooperative_groups;

#ifndef REP_P0
#define REP_P0 1
#endif
#ifndef REP_DNOUT
#define REP_DNOUT 1
#endif
#ifndef REP_G1
#define REP_G1 1
#endif
#ifndef REP_PREP
#define REP_PREP 1
#endif
#ifndef REP_SCAN
#define REP_SCAN 1
#endif
#ifndef REP_ATTN
#define REP_ATTN 1
#endif
#ifndef USE_COOP
#define USE_COOP 1
#endif

#define DI __device__ __forceinline__
typedef __attribute__((ext_vector_type(8))) short bf16x8;
typedef __attribute__((ext_vector_type(4))) short s16x4;
typedef __attribute__((ext_vector_type(4))) float f32x4;
typedef short v4i16_t __attribute__((ext_vector_type(4)));
typedef __attribute__((address_space(3))) const char* lds_cptr;
typedef unsigned short u16;

constexpr int SEQ = 2048, NTOK = 16384, DMODEL = 1024, NP = 4096, WIN_LD = 4104;
constexpr int C_DNQ = 0, C_DNK = 512, C_DNV = 1024, C_DNZ = 1536, C_DFQ = 2048, C_DFK = 2560, C_DFV = 3072, C_DFZ = 3584;
constexpr float EPSV = 1e-6f;
constexpr float LOG2E = 1.4426950408889634f;

constexpr size_t OFF_PROJ = 0;
constexpr size_t OFF_HB = 134217728;
constexpr size_t OFF_WTIN = OFF_HB + 33554432;
constexpr size_t OFF_WTOUT = OFF_WTIN + 8388608;
constexpr size_t OFF_G = OFF_WTOUT + 2097152;
constexpr size_t OFF_BETA = OFF_G + 262144;
constexpr size_t OFF_DN = OFF_BETA + 262144;
constexpr size_t DN_CHUNK_B = 73728;
constexpr size_t DN_NEGW = 0, DN_QG = 16384, DN_KD = 32768, DN_A = 49152, DN_U = 57344;
constexpr size_t OFF_GLAST = OFF_DN + DN_CHUNK_B * 1024;
constexpr size_t OFF_CTR = OFF_GLAST + 4096;
constexpr size_t OFF_BAR = OFF_CTR + 1024;

constexpr int SMEM_BYTES = 77824;

struct Params {
  const float *x, *norm_gain, *w_in, *conv_w, *a_log, *dt_bias, *dn_out_gain, *q_gain, *k_gain;
  const float *lq1, *lk1, *lq2, *lk2, *df_out_gain, *w_out;
  float* out;
  unsigned char* ws;
  int phase_lo, phase_hi, coop, pad0;
};

typedef __bf16 bf16x2_t __attribute__((ext_vector_type(2)));
DI unsigned cvtpk(float lo, float hi) { bf16x2_t v; v[0] = (__bf16)lo; v[1] = (__bf16)hi; return __builtin_bit_cast(unsigned, v); }
DI float bf2f(u16 h) { return __uint_as_float(((unsigned)h) << 16); }
DI float bflo(unsigned u) { return __uint_as_float(u << 16); }
DI float bfhi(unsigned u) { return __uint_as_float(u & 0xffff0000u); }
DI u16 f2bf(float x) { return (u16)(cvtpk(x, 0.f) & 0xffffu); }
template <int X> DI float lx(float v) { return __builtin_bit_cast(float, __builtin_amdgcn_ds_swizzle(__builtin_bit_cast(int, v), 0x1f | (X << 10))); }
DI float lx32_sum(float v) { auto rr = __builtin_amdgcn_permlane32_swap(__float_as_uint(v), __float_as_uint(v), false, false); return __uint_as_float(rr[0]) + __uint_as_float(rr[1]); }
DI float lx32_max(float v) { auto rr = __builtin_amdgcn_permlane32_swap(__float_as_uint(v), __float_as_uint(v), false, false); return fmaxf(__uint_as_float(rr[0]), __uint_as_float(rr[1])); }
DI float wave_sum(float v) {
  v += lx<1>(v); v += lx<2>(v); v += lx<4>(v); v += lx<8>(v); v += lx<16>(v);
  return lx32_sum(v);
}
DI int lane_id() { int l; asm volatile("v_mbcnt_lo_u32_b32 %0, -1, 0\n\tv_mbcnt_hi_u32_b32 %0, -1, %0" : "=v"(l)); return l; }
DI float silu_f(float y) { return y * __builtin_amdgcn_rcpf(1.f + __expf(-y)); }
DI s16x4 vtr(const char* p) { return __builtin_bit_cast(s16x4, __builtin_amdgcn_ds_read_tr16_b64_v4i16((__attribute__((address_space(3))) v4i16_t*)(lds_cptr)p)); }
#define MFMA16(a, b, c) __builtin_amdgcn_mfma_f32_16x16x32_bf16((a), (b), (c), 0, 0, 0)
DI bf16x8 pack8(const f32x4& a, const f32x4& b) {
  uint4 u; u.x = cvtpk(a[0], a[1]); u.y = cvtpk(a[2], a[3]); u.z = cvtpk(b[0], b[1]); u.w = cvtpk(b[2], b[3]);
  return __builtin_bit_cast(bf16x8, u);
}

DI void p0_fill_w8(const Params& p, char* smem, int wv) {
  int tid_ = (wv << 6) | lane_id(); asm volatile("" : "+v"(tid_)); const int tid = tid_;
  float4* pl = (float4*)smem;
#pragma unroll
  for (int j = 0; j < 8; ++j) {
    const int q = tid + 256 * j, k = q >> 1, c4 = q & 1;
    pl[(c4 * 4 + (k & 3)) * 256 + (k >> 2)] = *(const float4*)(p.w_in + (size_t)k * WIN_LD + 2048 + 4 * c4);
  }
}
DI void p0_rows(const Params& p, int item, char* smem, int wv) {
  int tid_ = (wv << 6) | lane_id(); asm volatile("" : "+v"(tid_)); const int tid = tid_, wave = tid >> 6, lane = tid & 63;
  const int row = item * 4 + wave;
  const float4* pl = (const float4*)smem;
  const float4* xr = (const float4*)(p.x + (size_t)row * 1024);
  float4 xv[4]; float ss = 0.f;
  float acc[8];
#pragma unroll
  for (int j = 0; j < 8; ++j) acc[j] = 0.f;
#pragma unroll
  for (int i = 0; i < 4; ++i) {
    { const f32x4 t4 = __builtin_nontemporal_load((const f32x4*)xr + lane + 64 * i); xv[i] = make_float4(t4[0], t4[1], t4[2], t4[3]); }
    const float4 g = ((const float4*)p.norm_gain)[lane + 64 * i];
    ss += xv[i].x * xv[i].x + xv[i].y * xv[i].y + xv[i].z * xv[i].z + xv[i].w * xv[i].w;
    xv[i].x *= g.x; xv[i].y *= g.y; xv[i].z *= g.z; xv[i].w *= g.w;
    const float hh[4] = {xv[i].x, xv[i].y, xv[i].z, xv[i].w};
#pragma unroll
    for (int e = 0; e < 4; ++e) {
      const float4 w0 = pl[(0 + e) * 256 + lane + 64 * i], w1 = pl[(4 + e) * 256 + lane + 64 * i];
      acc[0] += hh[e] * w0.x; acc[1] += hh[e] * w0.y; acc[2] += hh[e] * w0.z; acc[3] += hh[e] * w0.w;
      acc[4] += hh[e] * w1.x; acc[5] += hh[e] * w1.y; acc[6] += hh[e] * w1.z; acc[7] += hh[e] * w1.w;
    }
  }
  ss = wave_sum(ss);
#pragma unroll
  for (int j = 0; j < 8; ++j) acc[j] = wave_sum(acc[j]);
  const float rstd = rsqrtf(ss * (1.f / 1024.f) + EPSV);
  u16* hb = (u16*)(p.ws + OFF_HB);
#pragma unroll
  for (int i = 0; i < 4; ++i) {
    uint2 pk; pk.x = cvtpk(xv[i].x * rstd, xv[i].y * rstd); pk.y = cvtpk(xv[i].z * rstd, xv[i].w * rstd);
    *(uint2*)(hb + (size_t)row * 1024 + (lane + 64 * i) * 4) = pk;
  }
  if (lane < 8) {
    float v = acc[0];
    v = lane == 1 ? acc[1] : v; v = lane == 2 ? acc[2] : v; v = lane == 3 ? acc[3] : v;
    v = lane == 4 ? acc[4] : v; v = lane == 5 ? acc[5] : v; v = lane == 6 ? acc[6] : v; v = lane == 7 ? acc[7] : v;
    v *= rstd;
    const int hd = lane & 3;
    if (lane < 4) {
      ((float*)(p.ws + OFF_BETA))[row * 4 + hd] = 1.f / (1.f + expf(-v));
    } else {
      const float a = v + p.dt_bias[hd];
      const float sp = fmaxf(a, 0.f) + log1pf(expf(-fabsf(a)));
      ((float*)(p.ws + OFF_G))[row * 4 + hd] = -expf(p.a_log[hd]) * sp;
    }
  }
}

DI void p0_transpose(const float* __restrict__ W, int ldw, bool is_win, u16* __restrict__ Wt, int kt, int nt, char* smem, int wv) {
  float* tile = (float*)smem;
  int tid_ = (wv << 6) | lane_id(); asm volatile("" : "+v"(tid_)); const int tid = tid_;
  const int c = tid & 63;
  const int n = nt * 64 + c;
  const int col = n + ((is_win && n >= 2048) ? 8 : 0);
#pragma unroll
  for (int i = 0; i < 16; ++i) {
    const int r = (tid >> 6) + 4 * i;
    tile[r * 65 + c] = __builtin_nontemporal_load(W + (size_t)(kt * 64 + r) * ldw + col);
  }
  __syncthreads();
  const int nn = tid >> 2, kp = (tid & 3) * 16;
  unsigned pk[8];
#pragma unroll
  for (int e = 0; e < 8; ++e) pk[e] = cvtpk(tile[(kp + 2 * e) * 65 + nn], tile[(kp + 2 * e + 1) * 65 + nn]);
  uint4* dst = (uint4*)(Wt + (size_t)(nt * 64 + nn) * 1024 + kt * 64 + kp);
  dst[0] = make_uint4(pk[0], pk[1], pk[2], pk[3]);
  dst[1] = make_uint4(pk[4], pk[5], pk[6], pk[7]);
  __syncthreads();
}

template <int EPI>
DI void gemm_tile(const Params& p, const u16* __restrict__ A, const u16* __restrict__ Bt, int m0, int n0, char* smem, int wv) {
  constexpr int K = 1024, NKT = K / 64;
  int tid_ = (wv << 6) | lane_id(); asm volatile("" : "+v"(tid_)); const int tid = tid_, wave = tid >> 6, lane = tid & 63, fr = lane & 15, fq = lane >> 4, wr = wave >> 1, wc = wave & 1;
  f32x4 acc[4][4];
#pragma unroll
  for (int i = 0; i < 4; ++i)
#pragma unroll
    for (int j = 0; j < 4; ++j) acc[i][j] = f32x4{0.f, 0.f, 0.f, 0.f};
  float4 xin[4][4];
  if (EPI == 2) {
#pragma unroll
    for (int mt = 0; mt < 4; ++mt)
#pragma unroll
      for (int nt = 0; nt < 4; ++nt)
        { const f32x4 t4 = __builtin_nontemporal_load((const f32x4*)(p.x + (size_t)(m0 + wr * 64 + mt * 16 + fr) * 1024 + n0 + wc * 64 + nt * 16 + 4 * fq));
          xin[mt][nt] = make_float4(t4[0], t4[1], t4[2], t4[3]); }
  }
  char* As = smem; char* Bs = smem + 32768;
  const int srow = tid >> 3, sc8 = (tid & 7) ^ ((tid >> 4) & 7);
  const u16* ag = A + (size_t)(m0 + srow) * K + sc8 * 8;
  const u16* bg = Bt + (size_t)(n0 + srow) * K + sc8 * 8;
#define G_GLDS(nb_, kt_) { _Pragma("unroll") for (int i = 0; i < 4; ++i) { \
    __builtin_amdgcn_global_load_lds((const unsigned*)(ag + (size_t)(32 * i) * K + (kt_) * 64), (unsigned*)(As + (nb_) + wv * 1024 + i * 4096), 16, 0, 0); \
    __builtin_amdgcn_global_load_lds((const unsigned*)(bg + (size_t)(32 * i) * K + (kt_) * 64), (unsigned*)(Bs + (nb_) + wv * 1024 + i * 4096), 16, 0, 0); } }
  G_GLDS(0, 0);
  __syncthreads();
  const int fsw = fr >> 1;
  for (int kt = 0; kt < NKT; ++kt) {
    const int buf = (kt & 1) * 16384;
    if (kt + 1 < NKT) G_GLDS(((kt + 1) & 1) * 16384, kt + 1);
#pragma unroll
    for (int ks = 0; ks < 2; ++ks) {
      bf16x8 af[4], bfr[4];
      const int sw = ((ks * 4 + fq) ^ fsw) << 4;
#pragma unroll
      for (int mt = 0; mt < 4; ++mt) af[mt] = *(const bf16x8*)(As + buf + (wr * 64 + mt * 16 + fr) * 128 + sw);
#pragma unroll
      for (int nt = 0; nt < 4; ++nt) bfr[nt] = *(const bf16x8*)(Bs + buf + (wc * 64 + nt * 16 + fr) * 128 + sw);
#pragma unroll
      for (int mt = 0; mt < 4; ++mt)
#pragma unroll
        for (int nt = 0; nt < 4; ++nt) acc[mt][nt] = MFMA16(bfr[nt], af[mt], acc[mt][nt]);
    }
    __syncthreads();
  }
  float qsc[4]; float4 qg4[4];
#pragma unroll
  for (int i = 0; i < 4; ++i) { qsc[i] = 1.f; qg4[i] = make_float4(1.f, 1.f, 1.f, 1.f); }
  if (EPI == 1 && n0 >= C_DFQ && n0 < C_DFV) {
    const bool isq = n0 < C_DFK;
    const float* gp = isq ? p.q_gain : p.k_gain;
#pragma unroll
    for (int nt = 0; nt < 4; ++nt) qg4[nt] = *(const float4*)(gp + nt * 16 + 4 * fq);
#pragma unroll
    for (int mt = 0; mt < 4; ++mt) {
      float ss = 0.f;
#pragma unroll
      for (int nt = 0; nt < 4; ++nt) ss += acc[mt][nt][0] * acc[mt][nt][0] + acc[mt][nt][1] * acc[mt][nt][1] + acc[mt][nt][2] * acc[mt][nt][2] + acc[mt][nt][3] * acc[mt][nt][3];
      ss += lx<16>(ss); ss = lx32_sum(ss);
      qsc[mt] = rsqrtf(ss * (1.f / 64.f) + EPSV) * (isq ? 0.125f * LOG2E : 1.f);
    }
  }
#pragma unroll
  for (int mt = 0; mt < 4; ++mt) {
    const int m = m0 + wr * 64 + mt * 16 + fr;
#pragma unroll
    for (int nt = 0; nt < 4; ++nt) {
      const int n = n0 + wc * 64 + nt * 16 + 4 * fq;
      if (EPI == 1) {
        u16* proj = (u16*)(p.ws + OFF_PROJ);
        uint2 pk; pk.x = cvtpk(acc[mt][nt][0] * qsc[mt] * qg4[nt].x, acc[mt][nt][1] * qsc[mt] * qg4[nt].y);
        pk.y = cvtpk(acc[mt][nt][2] * qsc[mt] * qg4[nt].z, acc[mt][nt][3] * qsc[mt] * qg4[nt].w);
        *(uint2*)(proj + (size_t)m * NP + n) = pk;
      } else {
        const float4 xi = xin[mt][nt];
        float4 o; o.x = xi.x + acc[mt][nt][0]; o.y = xi.y + acc[mt][nt][1]; o.z = xi.z + acc[mt][nt][2]; o.w = xi.w + acc[mt][nt][3];
        *(float4*)(p.out + (size_t)m * 1024 + n) = o;
      }
    }
  }
}

DI void p2_qknorm(const Params& p, int item, int wv) {
  int tid_ = (wv << 6) | lane_id(); asm volatile("" : "+v"(tid_)); const int tid = tid_, wave = tid >> 6, lane = tid & 63;
  const int row = item * 4 + wave;
  u16* pr = (u16*)(p.ws + OFF_PROJ) + (size_t)row * NP + C_DFQ + lane * 16;
  uint4 v0 = ((const uint4*)pr)[0], v1 = ((const uint4*)pr)[1];
  unsigned w[8] = {v0.x, v0.y, v0.z, v0.w, v1.x, v1.y, v1.z, v1.w};
  float f[16]; float ss = 0.f;
#pragma unroll
  for (int e = 0; e < 8; ++e) { f[2 * e] = bflo(w[e]); f[2 * e + 1] = bfhi(w[e]); ss += f[2 * e] * f[2 * e] + f[2 * e + 1] * f[2 * e + 1]; }
  ss += lx<1>(ss); ss += lx<2>(ss);
  const float rstd = rsqrtf(ss * (1.f / 64.f) + EPSV);
  const bool isq = lane < 32;
  const float* gp = (isq ? p.q_gain : p.k_gain) + (lane & 3) * 16;
  const float sc = rstd * (isq ? 0.125f * LOG2E : 1.f);
  unsigned o[8];
#pragma unroll
  for (int e = 0; e < 8; ++e) o[e] = cvtpk(f[2 * e] * sc * gp[2 * e], f[2 * e + 1] * sc * gp[2 * e + 1]);
  ((uint4*)pr)[0] = make_uint4(o[0], o[1], o[2], o[3]);
  ((uint4*)pr)[1] = make_uint4(o[4], o[5], o[6], o[7]);
}

DI void p2_prep(const Params& p, int item, char* smem, int wv, int next_item) {
  int tid_ = (wv << 6) | lane_id(); asm volatile("" : "+v"(tid_)); const int tid = tid_, wave = tid >> 6, lane = tid & 63, fr = lane & 15, fq = lane >> 4;
  const int n = item & 31, h = (item >> 5) & 3, b = item >> 7;
  u16* qn = (u16*)smem;
  u16* kn = (u16*)(smem + 17408);
  u16* vb = (u16*)(smem + 34816);
  u16* Mb = (u16*)(smem + 51200);
  float* Md = (float*)(smem + 59392);
  u16* Dv = (u16*)(smem + 63488);
  u16* Asm = (u16*)(smem + 67584);
  float* gcs = (float*)(smem + 75776);
  float* bts = gcs + 64;
  float* egs = bts + 64;
  float* kds = egs + 64;
  const size_t tok0 = (size_t)b * SEQ + n * 64;
  const u16* proj = (const u16*)(p.ws + OFF_PROJ);
  unsigned char* dnb = p.ws + OFF_DN + (size_t)item * DN_CHUNK_B;
  unsigned warm = 0u;

  if (wave == 0) {
    egs[lane] = ((const float*)(p.ws + OFF_G))[(tok0 + lane) * 4 + h];
    float gv = 0.f;
    for (int i = 0; i < 64; ++i) { const float t = egs[i]; gv += (i <= lane) ? t : 0.f; }
    gcs[lane] = gv;
    bts[lane] = ((const float*)(p.ws + OFF_BETA))[(tok0 + lane) * 4 + h];
    egs[lane] = __expf(gv);
    kds[lane] = __expf(__uint_as_float(__builtin_amdgcn_readlane(__float_as_uint(gv), 63)) - gv);
    if (lane == 63) ((float*)(p.ws + OFF_GLAST))[item] = gv;
  }
  {
    const int t0 = wave * 16;
    const u16* pcol = proj + h * 128 + 2 * lane;
    unsigned uq[19], uk[19], uv[19];
#pragma unroll
    for (int j = 0; j < 19; ++j) {
      const int tt = n * 64 + t0 - 3 + j;
      uq[j] = 0u; uk[j] = 0u; uv[j] = 0u;
      if (tt >= 0) {
        const u16* pp = pcol + ((size_t)b * SEQ + tt) * NP;
        uq[j] = __builtin_nontemporal_load((const unsigned*)(pp + C_DNQ)); uk[j] = __builtin_nontemporal_load((const unsigned*)(pp + C_DNK)); uv[j] = __builtin_nontemporal_load((const unsigned*)(pp + C_DNV));
      }
    }
    float2 cwq[4], cwk[4], cwv[4];
#pragma unroll
    for (int j = 0; j < 4; ++j) {
      cwq[j] = *(const float2*)(p.conv_w + j * 1536 + h * 128 + 2 * lane);
      cwk[j] = *(const float2*)(p.conv_w + j * 1536 + 512 + h * 128 + 2 * lane);
      cwv[j] = *(const float2*)(p.conv_w + j * 1536 + 1024 + h * 128 + 2 * lane);
    }
    asm volatile("" ::: "memory");
    if (next_item >= 0) {
      const int n2 = next_item & 31, h2 = (next_item >> 5) & 3, b2 = next_item >> 7;
#pragma unroll
      for (int j2 = 0; j2 < 2; ++j2) {
        const int idx = tid + 256 * j2;
        if (idx < 402) {
          const int r = idx / 6, m = (idx % 6) >> 1, hf = idx & 1;
          int tt2 = n2 * 64 - 3 + r; tt2 = tt2 < 0 ? 0 : tt2;
          const u16* tp = proj + ((size_t)b2 * SEQ + tt2) * NP + m * 512 + h2 * 128 + hf * 64;
          asm volatile("global_load_dword %0, %1, off" : "+v"(warm) : "v"(tp) : "memory");
        }
      }
    }
    float yqx[16], yqy[16], ykx[16], yky[16], sq[16], sk[16];
#pragma unroll
    for (int tt = 0; tt < 16; ++tt) {
      float ax = 0.f, ay = 0.f, bx = 0.f, by = 0.f, cx = 0.f, cy = 0.f;
#pragma unroll
      for (int j = 0; j < 4; ++j) {
        ax += cwq[j].x * bflo(uq[tt + j]); ay += cwq[j].y * bfhi(uq[tt + j]);
        bx += cwk[j].x * bflo(uk[tt + j]); by += cwk[j].y * bfhi(uk[tt + j]);
        cx += cwv[j].x * bflo(uv[tt + j]); cy += cwv[j].y * bfhi(uv[tt + j]);
      }
      ax = silu_f(ax); ay = silu_f(ay); bx = silu_f(bx); by = silu_f(by); cx = silu_f(cx); cy = silu_f(cy);
      yqx[tt] = ax; yqy[tt] = ay; ykx[tt] = bx; yky[tt] = by;
      sq[tt] = ax * ax + ay * ay; sk[tt] = bx * bx + by * by;
      *(unsigned*)(vb + (t0 + tt) * 128 + 2 * lane) = cvtpk(cx, cy);
    }
#define RED_STEP(X) { _Pragma("unroll") for (int tt = 0; tt < 16; ++tt) { sq[tt] += lx<X>(sq[tt]); sk[tt] += lx<X>(sk[tt]); } }
    RED_STEP(1) RED_STEP(2) RED_STEP(4) RED_STEP(8) RED_STEP(16)
#pragma unroll
    for (int tt = 0; tt < 16; ++tt) {
      const float rq = rsqrtf(lx32_sum(sq[tt]) + EPSV) * 0.08838834764831845f;
      const float rk = rsqrtf(lx32_sum(sk[tt]) + EPSV);
      *(unsigned*)(qn + (t0 + tt) * 136 + 2 * lane) = cvtpk(yqx[tt] * rq, yqy[tt] * rq);
      *(unsigned*)(kn + (t0 + tt) * 136 + 2 * lane) = cvtpk(ykx[tt] * rk, yky[tt] * rk);
    }
  }
  __syncthreads();
  {
    f32x4 akk[4], aqk[4];
#pragma unroll
    for (int i = 0; i < 4; ++i) { akk[i] = f32x4{0.f, 0.f, 0.f, 0.f}; aqk[i] = f32x4{0.f, 0.f, 0.f, 0.f}; }
#pragma unroll
    for (int ks = 0; ks < 4; ++ks) {
      const bf16x8 ak = *(const bf16x8*)((const char*)kn + (16 * wave + fr) * 272 + (32 * ks + 8 * fq) * 2);
      const bf16x8 aq = *(const bf16x8*)((const char*)qn + (16 * wave + fr) * 272 + (32 * ks + 8 * fq) * 2);
#pragma unroll
      for (int nt = 0; nt < 4; ++nt) {
        if (nt <= wave) {
          const bf16x8 bk = *(const bf16x8*)((const char*)kn + (16 * nt + fr) * 272 + (32 * ks + 8 * fq) * 2);
          akk[nt] = MFMA16(ak, bk, akk[nt]);
          aqk[nt] = MFMA16(aq, bk, aqk[nt]);
        }
      }
    }
#pragma unroll
    for (int nt = 0; nt < 4; ++nt)
#pragma unroll
      for (int j = 0; j < 4; ++j) {
        const int c = 16 * wave + 4 * fq + j, s = 16 * nt + fr;
        const float dec = (s <= c) ? __expf(gcs[c] - gcs[s]) : 0.f;
        const float mv = (s < c) ? bts[c] * akk[nt][j] * dec : 0.f;
        Mb[c * 64 + s] = f2bf(-mv);
        if (nt == wave) Md[wave * 256 + (c & 15) * 16 + (s & 15)] = mv;
        Asm[c * 64 + s] = f2bf((s <= c) ? aqk[nt][j] * dec : 0.f);
      }
    {
      const float* md = Md + wave * 256;
      float t[16];
#pragma unroll
      for (int i = 0; i < 16; ++i) t[i] = (i == lane) ? 1.f : 0.f;
#pragma unroll
      for (int j = 0; j < 15; ++j)
#pragma unroll
        for (int i = j + 1; i < 16; ++i) t[i] -= md[i * 16 + j] * t[j];
      if (lane < 16) {
#pragma unroll
        for (int i = 0; i < 16; ++i) Dv[wave * 256 + i * 16 + lane] = f2bf(t[i]);
      }
    }
  }
  __syncthreads();
  {
    const float glast = gcs[63];
#pragma unroll
    for (int it = 0; it < 4; ++it) {
      const int pp = tid + 256 * it;
      const int frag = pp >> 6, l2 = pp & 63, m = l2 & 15, qq = l2 >> 4;
      {
        const int mt = frag >> 2, ks = frag & 3, row = 16 * mt + m;
        const uint2 lo = *(const uint2*)((const char*)qn + row * 272 + (32 * ks + 4 * qq) * 2);
        const uint2 hi = *(const uint2*)((const char*)qn + row * 272 + (32 * ks + 16 + 4 * qq) * 2);
        const float e = egs[row];
        uint4 o;
        o.x = cvtpk(bflo(lo.x) * e, bfhi(lo.x) * e); o.y = cvtpk(bflo(lo.y) * e, bfhi(lo.y) * e);
        o.z = cvtpk(bflo(hi.x) * e, bfhi(hi.x) * e); o.w = cvtpk(bflo(hi.y) * e, bfhi(hi.y) * e);
        *(uint4*)(dnb + DN_QG + (size_t)pp * 16) = o;
      }
      {
        const int mtk = frag >> 1, ks = frag & 1, dk = 16 * mtk + m;
        float v[8];
#pragma unroll
        for (int j = 0; j < 8; ++j) {
          const int c = 32 * ks + ((j >> 2) << 4) + 4 * qq + (j & 3);
          v[j] = bf2f(kn[c * 136 + dk]) * kds[c];
        }
        uint4 o; o.x = cvtpk(v[0], v[1]); o.y = cvtpk(v[2], v[3]); o.z = cvtpk(v[4], v[5]); o.w = cvtpk(v[6], v[7]);
        *(uint4*)(dnb + DN_KD + (size_t)pp * 16) = o;
      }
      if (it < 2) {
        const int mt = frag >> 1, ks = frag & 1, row = 16 * mt + m;
        const uint2 lo = *(const uint2*)((const char*)Asm + row * 128 + (32 * ks + 4 * qq) * 2);
        const uint2 hi = *(const uint2*)((const char*)Asm + row * 128 + (32 * ks + 16 + 4 * qq) * 2);
        *(uint4*)(dnb + DN_A + (size_t)pp * 16) = make_uint4(lo.x, lo.y, hi.x, hi.y);
      }
    }
  }
  const bool isv = wave < 2;
  f32x4 Xs[4][4];
  {
    const f32x4 z4 = f32x4{0.f, 0.f, 0.f, 0.f};
    bf16x8 dinv[4], m10, m20, m30, m31;
#pragma unroll
    for (int I = 0; I < 4; ++I) {
      const uint2 lo = *(const uint2*)(Dv + I * 256 + fr * 16 + 4 * fq);
      dinv[I] = __builtin_bit_cast(bf16x8, make_uint4(lo.x, lo.y, 0u, 0u));
    }
#define MBFRAG(I_, P_) __builtin_bit_cast(bf16x8, make_uint4(((const uint2*)(Mb + (16 * (I_) + fr) * 64 + 32 * (P_) + 4 * fq))->x, ((const uint2*)(Mb + (16 * (I_) + fr) * 64 + 32 * (P_) + 4 * fq))->y, \
                                                              ((const uint2*)(Mb + (16 * (I_) + fr) * 64 + 32 * (P_) + 16 + 4 * fq))->x, ((const uint2*)(Mb + (16 * (I_) + fr) * 64 + 32 * (P_) + 16 + 4 * fq))->y))
    m10 = MBFRAG(1, 0); m20 = MBFRAG(2, 0); m30 = MBFRAG(3, 0); m31 = MBFRAG(3, 1);
#pragma unroll
    for (int nt = 0; nt < 4; ++nt) {
      const int colx = (64 * wave + 16 * nt + fr) & 127;
      const u16* srcp = isv ? (vb + colx) : (kn + colx);
      const int sst = isv ? 128 : 136;
      f32x4 R[4];
#pragma unroll
      for (int I = 0; I < 4; ++I)
#pragma unroll
        for (int j = 0; j < 4; ++j) {
          const int row = 16 * I + 4 * fq + j;
          R[I][j] = bf2f(srcp[row * sst]) * bts[row] * (isv ? 1.f : egs[row]);
        }
      const f32x4 X0 = MFMA16(dinv[0], pack8(R[0], z4), z4);
      const f32x4 Y1 = MFMA16(m10, pack8(X0, z4), R[1]);
      const f32x4 X1 = MFMA16(dinv[1], pack8(Y1, z4), z4);
      const bf16x8 x01 = pack8(X0, X1);
      const f32x4 Y2 = MFMA16(m20, x01, R[2]);
      const f32x4 X2 = MFMA16(dinv[2], pack8(Y2, z4), z4);
      f32x4 Y3 = MFMA16(m30, x01, R[3]);
      Y3 = MFMA16(m31, pack8(X2, z4), Y3);
      const f32x4 X3 = MFMA16(dinv[3], pack8(Y3, z4), z4);
      Xs[nt][0] = X0; Xs[nt][1] = X1; Xs[nt][2] = X2; Xs[nt][3] = X3;
    }
  }
  if (isv) {
#pragma unroll
    for (int nt = 0; nt < 4; ++nt)
#pragma unroll
      for (int I = 0; I < 4; ++I) {
        uint2 o; o.x = cvtpk(Xs[nt][I][0], Xs[nt][I][1]); o.y = cvtpk(Xs[nt][I][2], Xs[nt][I][3]);
        *(uint2*)(dnb + DN_U + (size_t)(((I * 8 + 4 * wave + nt) * 64 + lane) * 8)) = o;
      }
  }
  __syncthreads();
  if (!isv) {
#pragma unroll
    for (int nt = 0; nt < 4; ++nt) {
      const int colx = (64 * wave + 16 * nt + fr) & 127;
#pragma unroll
      for (int I = 0; I < 4; ++I)
#pragma unroll
        for (int j = 0; j < 4; ++j) qn[(16 * I + 4 * fq + j) * 136 + colx] = f2bf(-Xs[nt][I][j]);
    }
  }
  __syncthreads();
#pragma unroll
  for (int it = 0; it < 4; ++it) {
    const int pp = tid + 256 * it;
    const int frag = pp >> 6, l2 = pp & 63, m = l2 & 15, qq = l2 >> 4;
    const int mt = frag >> 2, ks = frag & 3, row = 16 * mt + m;
    const uint2 lo = *(const uint2*)((const char*)qn + row * 272 + (32 * ks + 4 * qq) * 2);
    const uint2 hi = *(const uint2*)((const char*)qn + row * 272 + (32 * ks + 16 + 4 * qq) * 2);
    *(uint4*)(dnb + DN_NEGW + (size_t)pp * 16) = make_uint4(lo.x, lo.y, hi.x, hi.y);
  }
  asm volatile("s_waitcnt vmcnt(0)" ::: "memory");
  asm volatile("" :: "v"(warm));
  __syncthreads();
}

constexpr size_t OUT_SN = 0;
constexpr size_t OUT_VN = 33554432;
DI void p3_scan(const Params& p, int bh, char* smem, int wv) {
  int tid_ = (wv << 6) | lane_id(); asm volatile("" : "+v"(tid_)); const int tid = tid_, wave = tid >> 6, lane = tid & 63;
  f32x4 S[8][2]; bf16x8 Sb[4][2];
#pragma unroll
  for (int i = 0; i < 8; ++i) { S[i][0] = f32x4{0.f, 0.f, 0.f, 0.f}; S[i][1] = f32x4{0.f, 0.f, 0.f, 0.f}; }
#pragma unroll
  for (int i = 0; i < 4; ++i) { Sb[i][0] = bf16x8{0, 0, 0, 0, 0, 0, 0, 0}; Sb[i][1] = bf16x8{0, 0, 0, 0, 0, 0, 0, 0}; }
  char* L = smem;
  float* egl_s = (float*)(smem + 65536);
  const unsigned char* dn0 = p.ws + OFF_DN + (size_t)(bh * 32) * DN_CHUNK_B;
  unsigned char* sn0 = (unsigned char*)p.out + OUT_SN + (size_t)(bh * 32) * 32768;
  unsigned char* vn0 = (unsigned char*)p.out + OUT_VN + (size_t)(bh * 32) * 16384;
  if (tid < 32) egl_s[tid] = __expf(((const float*)(p.ws + OFF_GLAST))[bh * 32 + tid]);
  uint4 r0, r1, r2, r3, r4, r5, r6, r7; uint2 un[8];
#define SC_NT4(p_) __builtin_bit_cast(uint4, __builtin_nontemporal_load((const f32x4*)(p_)))
#define SC_LOADC(n_) { const uint4* a_ = (const uint4*)(dn0 + (size_t)(n_) * DN_CHUNK_B + DN_NEGW) + tid; \
                       const uint4* b_ = (const uint4*)(dn0 + (size_t)(n_) * DN_CHUNK_B + DN_KD) + tid; \
                       r0 = SC_NT4(a_); r1 = SC_NT4(a_ + 256); r2 = SC_NT4(a_ + 512); r3 = SC_NT4(a_ + 768); \
                       r4 = SC_NT4(b_); r5 = SC_NT4(b_ + 256); r6 = SC_NT4(b_ + 512); r7 = SC_NT4(b_ + 768); }
#define SC_LOADU(dst, n_) { const uint2* u_ = (const uint2*)(dn0 + (size_t)(n_) * DN_CHUNK_B + DN_U) + lane; \
                            dst[0] = u_[(0 + 2 * wave) * 64]; dst[1] = u_[(0 + 2 * wave + 1) * 64]; dst[2] = u_[(8 + 2 * wave) * 64]; dst[3] = u_[(8 + 2 * wave + 1) * 64]; \
                            dst[4] = u_[(16 + 2 * wave) * 64]; dst[5] = u_[(16 + 2 * wave + 1) * 64]; dst[6] = u_[(24 + 2 * wave) * 64]; dst[7] = u_[(24 + 2 * wave + 1) * 64]; }
#define SC_STOREL(buf) { uint4* l_ = (uint4*)(L + (buf) * 32768) + tid; \
                         l_[0] = r0; l_[256] = r1; l_[512] = r2; l_[768] = r3; l_[1024] = r4; l_[1280] = r5; l_[1536] = r6; l_[1792] = r7; }
  unsigned warm = 0u;
  const unsigned char* tbase = dn0 + (wv & 1) * 8192 + (wv >> 1) * 32768;
  const unsigned char* ubase = dn0 + DN_U + (wv & 1) * 8192;
#define SC_TOUCH(n_) { const unsigned toff_ = (unsigned)lane * 128u; \
    asm volatile("global_load_dword %0, %1, %2" : "+v"(warm) : "v"(toff_), "s"(tbase + (size_t)(n_) * DN_CHUNK_B) : "memory"); \
    asm volatile("global_load_dword %0, %1, %2" : "+v"(warm) : "v"(toff_), "s"(ubase + (size_t)(n_) * DN_CHUNK_B) : "memory"); }
  SC_TOUCH(2); SC_TOUCH(3); SC_TOUCH(4);
  SC_LOADC(0); SC_LOADU(un, 0); SC_STOREL(0);
  __syncthreads();
  SC_LOADC(1);
  for (int n = 0; n < 32; ++n) {
    const char* B = L + (n & 1) * 32768 + lane * 16;
    if (n + 5 < 32) SC_TOUCH(n + 5);
    f32x4 av[4][2];
#pragma unroll
    for (int mt = 0; mt < 4; ++mt)
#pragma unroll
      for (int nt = 0; nt < 2; ++nt) { const uint2 u2 = un[mt * 2 + nt]; av[mt][nt] = f32x4{bflo(u2.x), bfhi(u2.x), bflo(u2.y), bfhi(u2.y)}; }
    if (n + 1 < 32) SC_LOADU(un, n + 1);
#pragma unroll
    for (int mt = 0; mt < 4; ++mt)
#pragma unroll
      for (int ks = 0; ks < 4; ++ks) {
        const bf16x8 af = *(const bf16x8*)(B + (mt * 4 + ks) * 1024);
        av[mt][0] = MFMA16(af, Sb[ks][0], av[mt][0]);
        av[mt][1] = MFMA16(af, Sb[ks][1], av[mt][1]);
      }
    bf16x8 vbf[2][2];
#pragma unroll
    for (int k2 = 0; k2 < 2; ++k2)
#pragma unroll
      for (int nt = 0; nt < 2; ++nt) vbf[k2][nt] = pack8(av[2 * k2][nt], av[2 * k2 + 1][nt]);
    {
      unsigned char* sn = sn0 + (size_t)n * 32768 + lane * 16;
      unsigned char* vn = vn0 + (size_t)n * 16384 + lane * 16;
#pragma unroll
      for (int ks = 0; ks < 4; ++ks)
#pragma unroll
        for (int nt = 0; nt < 2; ++nt) *(bf16x8*)(sn + (ks * 8 + 2 * wave + nt) * 1024) = Sb[ks][nt];
#pragma unroll
      for (int k2 = 0; k2 < 2; ++k2)
#pragma unroll
        for (int nt = 0; nt < 2; ++nt) *(bf16x8*)(vn + (k2 * 8 + 2 * wave + nt) * 1024) = vbf[k2][nt];
    }
    const float egl = egl_s[n];
#pragma unroll
    for (int mk = 0; mk < 8; ++mk) {
#pragma unroll
      for (int nt = 0; nt < 2; ++nt) { S[mk][nt][0] *= egl; S[mk][nt][1] *= egl; S[mk][nt][2] *= egl; S[mk][nt][3] *= egl; }
#pragma unroll
      for (int k2 = 0; k2 < 2; ++k2) {
        const bf16x8 af = *(const bf16x8*)(B + 16384 + (mk * 2 + k2) * 1024);
        S[mk][0] = MFMA16(af, vbf[k2][0], S[mk][0]);
        S[mk][1] = MFMA16(af, vbf[k2][1], S[mk][1]);
      }
    }
#pragma unroll
    for (int ks = 0; ks < 4; ++ks)
#pragma unroll
      for (int nt = 0; nt < 2; ++nt) Sb[ks][nt] = pack8(S[2 * ks][nt], S[2 * ks + 1][nt]);
    if (n + 1 < 32) SC_STOREL((n + 1) & 1);
    if (n + 2 < 32) SC_LOADC(n + 2);
    __syncthreads();
  }
  asm volatile("s_waitcnt vmcnt(0)" ::: "memory");
  asm volatile("" :: "v"(warm));
  __syncthreads();
  if (tid == 0) {
    __builtin_amdgcn_fence(__ATOMIC_RELEASE, "agent");
    asm volatile("s_waitcnt vmcnt(0)" ::: "memory");
    __hip_atomic_store((unsigned*)(p.ws + OFF_CTR) + 128 + bh, 1u, __ATOMIC_RELAXED, __HIP_MEMORY_SCOPE_AGENT);
  }
}

DI void p4_dnout(const Params& p, int ci, char* smem, int wv) {
  int tid_ = (wv << 6) | lane_id(); asm volatile("" : "+v"(tid_)); const int tid = tid_, wave = tid >> 6, lane = tid & 63, fr = lane & 15, fq = lane >> 4;
  const int n = ci & 31, h = (ci >> 5) & 3, b = ci >> 7;
  float* rd = (float*)smem;
  const unsigned char* base = p.ws + OFF_DN + (size_t)ci * DN_CHUNK_B;
  const uint4* qg = (const uint4*)(base + DN_QG) + lane;
  const uint4* aa = (const uint4*)(base + DN_A) + lane;
  const unsigned char* sn = (const unsigned char*)p.out + OUT_SN + (size_t)ci * 32768 + lane * 16;
  const unsigned char* vn = (const unsigned char*)p.out + OUT_VN + (size_t)ci * 16384 + lane * 16;
  bf16x8 Sb[4][2], vbf[2][2];
#pragma unroll
  for (int ks = 0; ks < 4; ++ks)
#pragma unroll
    for (int nt = 0; nt < 2; ++nt) Sb[ks][nt] = *(const bf16x8*)(sn + (ks * 8 + 2 * wave + nt) * 1024);
#pragma unroll
  for (int k2 = 0; k2 < 2; ++k2)
#pragma unroll
    for (int nt = 0; nt < 2; ++nt) vbf[k2][nt] = *(const bf16x8*)(vn + (k2 * 8 + 2 * wave + nt) * 1024);
  f32x4 ao[4][2];
#pragma unroll
  for (int mt = 0; mt < 4; ++mt) {
    ao[mt][0] = f32x4{0.f, 0.f, 0.f, 0.f}; ao[mt][1] = f32x4{0.f, 0.f, 0.f, 0.f};
#pragma unroll
    for (int ks = 0; ks < 4; ++ks) {
      const bf16x8 af = __builtin_bit_cast(bf16x8, qg[(mt * 4 + ks) * 64]);
      ao[mt][0] = MFMA16(af, Sb[ks][0], ao[mt][0]);
      ao[mt][1] = MFMA16(af, Sb[ks][1], ao[mt][1]);
    }
#pragma unroll
    for (int k2 = 0; k2 < 2; ++k2) {
      const bf16x8 af = __builtin_bit_cast(bf16x8, aa[(mt * 2 + k2) * 64]);
      ao[mt][0] = MFMA16(af, vbf[k2][0], ao[mt][0]);
      ao[mt][1] = MFMA16(af, vbf[k2][1], ao[mt][1]);
    }
  }
  float gn[2];
  gn[0] = p.dn_out_gain[32 * wave + fr]; gn[1] = p.dn_out_gain[32 * wave + 16 + fr];
  const u16* proj = (const u16*)(p.ws + OFF_PROJ);
  u16* mixed = (u16*)(p.ws + OFF_HB);
#pragma unroll
  for (int mt = 0; mt < 4; ++mt)
#pragma unroll
    for (int j = 0; j < 4; ++j) {
      float s = ao[mt][0][j] * ao[mt][0][j] + ao[mt][1][j] * ao[mt][1][j];
      s += lx<1>(s); s += lx<2>(s); s += lx<4>(s); s += lx<8>(s);
      if (fr == 0) rd[wave * 64 + 16 * mt + 4 * fq + j] = s;
    }
  __syncthreads();
#pragma unroll
  for (int mt = 0; mt < 4; ++mt)
#pragma unroll
    for (int j = 0; j < 4; ++j) {
      const int c = 16 * mt + 4 * fq + j;
      const float tot = rd[c] + rd[64 + c] + rd[128 + c] + rd[192 + c];
      const float rstd = rsqrtf(tot * (1.f / 128.f) + EPSV);
      const size_t tok = (size_t)b * SEQ + n * 64 + c;
#pragma unroll
      for (int nt = 0; nt < 2; ++nt) {
        const int dv = 32 * wave + 16 * nt + fr;
        const float z = bf2f(proj[tok * NP + C_DNZ + h * 128 + dv]);
        mixed[tok * 1024 + h * 128 + dv] = f2bf(ao[mt][nt][j] * rstd * gn[nt] * silu_f(z));
      }
    }
  __syncthreads();
}

DI void p3_attn(const Params& p, int bh, int qb, char* smem, int wv) {
  int tid_ = (wv << 6) | lane_id(); asm volatile("" : "+v"(tid_)); const int tid = tid_, wave = tid >> 6, lane = tid & 63, fr = lane & 15, fq = lane >> 4;
  const int b = bh >> 2, h = bh & 3;
  char* Ks = smem; char* Vs = smem + 32768;
  const u16* proj = (const u16*)(p.ws + OFF_PROJ);
  const size_t tokb = (size_t)b * SEQ;
  const int qrow = qb * 64 + 16 * wave + fr;
  bf16x8 qf[2][2];
#pragma unroll
  for (int mp = 0; mp < 2; ++mp)
#pragma unroll
    for (int ks = 0; ks < 2; ++ks) qf[mp][ks] = __builtin_bit_cast(bf16x8, __builtin_nontemporal_load((const f32x4*)(proj + (tokb + qrow) * NP + C_DFQ + h * 128 + mp * 64 + 32 * ks + 8 * fq)));
  f32x4 O[2][8];
#pragma unroll
  for (int mp = 0; mp < 2; ++mp)
#pragma unroll
    for (int i = 0; i < 8; ++i) O[mp][i] = f32x4{0.f, 0.f, 0.f, 0.f};
  float mrun[2] = {-INFINITY, -INFINITY}, lrun[2] = {0.f, 0.f};
  const int ntiles = qb + 1;
  const int srow = tid >> 4, c16 = tid & 15;
  const int koff = srow * 256 + ((c16 ^ (srow & 15)) << 4);
  const int voff = srow * 256 + (((c16 >> 1) ^ (srow & 7)) << 5) + ((c16 & 1) << 4);
  const u16* kg = proj + (tokb + srow) * NP + C_DFK + h * 128 + c16 * 8;
  const u16* vg = proj + (tokb + srow) * NP + C_DFV + h * 128 + c16 * 8;
  uint4 rk[4], rv[4];
#pragma unroll
  for (int i = 0; i < 4; ++i) { rk[i] = *(const uint4*)(kg + (size_t)(16 * i) * NP); rv[i] = *(const uint4*)(vg + (size_t)(16 * i) * NP); }
#pragma unroll
  for (int i = 0; i < 4; ++i) { *(uint4*)(Ks + koff + i * 4096) = rk[i]; *(uint4*)(Vs + voff + i * 4096) = rv[i]; }
  __syncthreads();
  const int trr = fr >> 2, trp = fr & 3;
  for (int kt = 0; kt < ntiles; ++kt) {
    const int buf = (kt & 1) * 16384;
    if (kt + 1 < ntiles) {
#pragma unroll
      for (int i = 0; i < 4; ++i) {
        rk[i] = *(const uint4*)(kg + (size_t)((kt + 1) * 64 + 16 * i) * NP);
        rv[i] = *(const uint4*)(vg + (size_t)((kt + 1) * 64 + 16 * i) * NP);
      }
    }
    f32x4 st[2][4];
#pragma unroll
    for (int mp = 0; mp < 2; ++mp)
#pragma unroll
      for (int mt = 0; mt < 4; ++mt) {
        st[mp][mt] = f32x4{0.f, 0.f, 0.f, 0.f};
#pragma unroll
        for (int ks = 0; ks < 2; ++ks) {
          const bf16x8 ka = *(const bf16x8*)(Ks + buf + (16 * mt + fr) * 256 + (((mp * 8 + ks * 4 + fq) ^ fr) << 4));
          st[mp][mt] = MFMA16(ka, qf[mp][ks], st[mp][mt]);
        }
      }
    if (kt == qb) {
#pragma unroll
      for (int mt = 0; mt < 4; ++mt)
#pragma unroll
        for (int j = 0; j < 4; ++j) {
          const int key = kt * 64 + 16 * mt + 4 * fq + j;
          if (key > qrow) { st[0][mt][j] = -INFINITY; st[1][mt][j] = -INFINITY; }
        }
    }
    bf16x8 pf[2][2];
#pragma unroll
    for (int mp = 0; mp < 2; ++mp) {
      float mx = st[mp][0][0];
#pragma unroll
      for (int mt = 0; mt < 4; ++mt)
#pragma unroll
        for (int j = 0; j < 4; ++j) mx = fmaxf(mx, st[mp][mt][j]);
      mx = fmaxf(mx, lx<16>(mx)); mx = lx32_max(mx);
      const float mnew = fmaxf(mrun[mp], mx);
      const float alpha = __builtin_amdgcn_exp2f(mrun[mp] - mnew);
      mrun[mp] = mnew;
      float ps = 0.f;
#pragma unroll
      for (int mt = 0; mt < 4; ++mt)
#pragma unroll
        for (int j = 0; j < 4; ++j) { const float e = __builtin_amdgcn_exp2f(st[mp][mt][j] - mnew); st[mp][mt][j] = e; ps += e; }
      lrun[mp] = lrun[mp] * alpha + ps;
      if (__builtin_amdgcn_ballot_w64(alpha != 1.f) != 0ull) {
#pragma unroll
        for (int i = 0; i < 8; ++i) { O[mp][i][0] *= alpha; O[mp][i][1] *= alpha; O[mp][i][2] *= alpha; O[mp][i][3] *= alpha; }
      }
      pf[mp][0] = pack8(st[mp][0], st[mp][1]);
      pf[mp][1] = pack8(st[mp][2], st[mp][3]);
    }
#pragma unroll
    for (int k2 = 0; k2 < 2; ++k2) {
      const int r0 = 32 * k2 + 4 * fq + trr, r1 = r0 + 16;
#pragma unroll
      for (int mv = 0; mv < 8; ++mv) {
        const s16x4 lo = vtr(Vs + buf + r0 * 256 + ((mv ^ (r0 & 7)) << 5) + 8 * trp);
        const s16x4 hi = vtr(Vs + buf + r1 * 256 + ((mv ^ (r1 & 7)) << 5) + 8 * trp);
        const bf16x8 va = __builtin_shufflevector(lo, hi, 0, 1, 2, 3, 4, 5, 6, 7);
        O[0][mv] = MFMA16(va, pf[0][k2], O[0][mv]);
        O[1][mv] = MFMA16(va, pf[1][k2], O[1][mv]);
      }
    }
    if (kt + 1 < ntiles) {
      const int nb = ((kt + 1) & 1) * 16384;
#pragma unroll
      for (int i = 0; i < 4; ++i) { *(uint4*)(Ks + nb + koff + i * 4096) = rk[i]; *(uint4*)(Vs + nb + voff + i * 4096) = rv[i]; }
    }
    __syncthreads();
  }
  int tid2 = (wv << 6) | lane_id(); asm volatile("" : "+v"(tid2));
  const int qrow_e = qb * 64 + 16 * (tid2 >> 6) + (tid2 & 15), fq_e = (tid2 >> 4) & 3;
  float inv[2];
#pragma unroll
  for (int mp = 0; mp < 2; ++mp) { float l = lrun[mp]; l += lx<16>(l); l = lx32_sum(l); inv[mp] = 1.f / l; }
  const float li = *(const float*)(smem + 73744) * inv[1];
  float ss = 0.f;
#pragma unroll
  for (int mv = 0; mv < 8; ++mv)
#pragma unroll
    for (int j = 0; j < 4; ++j) { const float o = O[0][mv][j] * inv[0] - li * O[1][mv][j]; O[0][mv][j] = o; ss += o * o; }
  ss += lx<16>(ss); ss = lx32_sum(ss);
  const float rstd = rsqrtf(ss * (1.f / 128.f) + EPSV) * 0.8f;
  u16* mixed = (u16*)(p.ws + OFF_HB);
#pragma unroll
  for (int mv = 0; mv < 8; ++mv) {
    const int dv = 16 * mv + 4 * fq_e;
    typedef unsigned u32x2 __attribute__((ext_vector_type(2)));
    const u32x2 zz_ = __builtin_nontemporal_load((const u32x2*)(proj + (tokb + qrow_e) * NP + C_DFZ + h * 128 + dv));
    const uint2 zz = make_uint2(zz_[0], zz_[1]);
    const float4 g4 = *(const float4*)(p.df_out_gain + dv);
    uint2 o;
    o.x = cvtpk(O[0][mv][0] * rstd * g4.x * silu_f(bflo(zz.x)), O[0][mv][1] * rstd * g4.y * silu_f(bfhi(zz.x)));
    o.y = cvtpk(O[0][mv][2] * rstd * g4.z * silu_f(bflo(zz.y)), O[0][mv][3] * rstd * g4.w * silu_f(bfhi(zz.y)));
    *(uint2*)(mixed + (tokb + qrow_e) * 1024 + 512 + h * 128 + dv) = o;
  }
}

#define XB_TMO      128
#define XB_XCNT(j)  (256  + 64 * (j))
#define XB_XSUB(j)  (1280 + 64 * (j))
#define XB_XGEN(j)  (2304 + 64 * (j))
#define XB_TOP      3328
#define XB_TOPGEN   3392
#define XCD_BAR_WORDS 3456
#define XB_SPIN_CAP (1u << 18)
#define LAS __attribute__((address_space(3)))
DI unsigned xb_ld(unsigned* p) { return __hip_atomic_load(p, __ATOMIC_RELAXED, __HIP_MEMORY_SCOPE_AGENT); }
DI unsigned xb_add(unsigned* p, unsigned v) { return __hip_atomic_fetch_add(p, v, __ATOMIC_RELAXED, __HIP_MEMORY_SCOPE_AGENT); }
DI unsigned xb_xcc_id() { return (unsigned)__builtin_amdgcn_s_getreg((3 << 11) | 20) & 0xFu; }
#define XB_SPIN(cond, bar) do { unsigned _sp = 0; while (cond) { __builtin_amdgcn_s_sleep(1); \
    if ((++_sp & 255u) == 0u) { if (xb_ld(&(bar)[XB_TMO])) break; if (_sp > XB_SPIN_CAP) { atomicAdd(&(bar)[XB_TMO], 1u); break; } } } } while (0)
DI void xcd_barrier_complete(unsigned* bar, unsigned x, unsigned& nloc, unsigned& nx) {
  const unsigned G = gridDim.x;
  unsigned sum, cnt, mine, sp = 0u;
  for (;;) {
    sum = 0u; cnt = 0u; mine = 0u;
#pragma unroll
    for (unsigned j = 0; j < 16; ++j) { const unsigned c = xb_ld(&bar[XB_XCNT(j)]); sum += c; cnt += (c > 0u) ? 1u : 0u; mine = (j == x) ? c : mine; }
    if (sum == G) break;
    __builtin_amdgcn_s_sleep(1);
    if ((++sp & 255u) == 0u) { if (xb_ld(&bar[XB_TMO])) break; if (sp > XB_SPIN_CAP) { atomicAdd(&bar[XB_TMO], 1u); break; } }
  }
  nloc = mine > 0u ? mine : 1u; nx = cnt > 0u ? cnt : 1u;
}
DI void xcd_barrier(unsigned* bar, volatile LAS unsigned* st, bool leader) {
  asm volatile("s_waitcnt vmcnt(0)" ::: "memory");
  __syncthreads();
  if (leader) {
    const unsigned x = xb_xcc_id();
    __builtin_amdgcn_s_waitcnt(0);
    unsigned nloc = st[0], nx = st[1];
    if (nloc == 0u) { xcd_barrier_complete(bar, x, nloc, nx); st[0] = nloc; st[1] = nx; }
    const unsigned old = xb_add(&bar[XB_XSUB(x)], 1u);
    const unsigned gen = old / nloc;
    if (old + 1u == (gen + 1u) * nloc) {
      __builtin_amdgcn_fence(__ATOMIC_RELEASE, "agent");
      asm volatile("s_waitcnt vmcnt(0)" ::: "memory");
      const unsigned og = xb_add(&bar[XB_TOP], 1u);
      const unsigned tg = og / nx;
      if (og + 1u == (tg + 1u) * nx) xb_add(&bar[XB_TOPGEN], 1u);
      else XB_SPIN(xb_ld(&bar[XB_TOPGEN]) == tg, bar);
      __builtin_amdgcn_fence(__ATOMIC_ACQUIRE, "agent");
      xb_add(&bar[XB_XGEN(x)], 1u);
      asm volatile("s_waitcnt vmcnt(0)" ::: "memory");
    } else {
      XB_SPIN(xb_ld(&bar[XB_XGEN(x)]) == gen, bar);
      __builtin_amdgcn_fence(__ATOMIC_ACQUIRE, "agent");
      asm volatile("s_waitcnt vmcnt(0)" ::: "memory");
    }
  }
  __syncthreads();
}

template <int ONLY>
__global__ void __launch_bounds__(256, 2) fwd_kernel(Params p) {
  __shared__ __attribute__((aligned(16))) char smem[SMEM_BYTES];
  const int nb = gridDim.x, bid = blockIdx.x;
  const int wv = __builtin_amdgcn_readfirstlane((int)(threadIdx.x >> 6));
  __shared__ uint4 xb_words;
  unsigned* const gbar = (unsigned*)(p.ws + OFF_BAR);
  volatile LAS unsigned* const xst = (volatile LAS unsigned*)&xb_words;
  if (ONLY < 0) {
    if (wv == 0 && lane_id() == 0) { xb_words = make_uint4(0u, 0u, 0u, 0u); (void)xb_add(&gbar[XB_XCNT(xb_xcc_id())], 1u); }
    __syncthreads();
    if (p.coop == 2) cg::this_grid().sync();
  }
#define GRID_SYNC() xcd_barrier(gbar, xst, wv == 0 && lane_id() == 0)
  if (ONLY < 0 || ONLY == 0) {
    if (bid == 0 && wv < 3) ((unsigned*)(p.ws + OFF_CTR))[(wv << 6) | lane_id()] = 0u;
    for (int it = bid; it < 1024 + 256; it += nb) {
      if (it < 1024) p0_transpose(p.w_in, WIN_LD, true, (u16*)(p.ws + OFF_WTIN), it & 15, it >> 4, smem, wv);
      else { const int t = it - 1024; p0_transpose(p.w_out, 1024, false, (u16*)(p.ws + OFF_WTOUT), t & 15, t >> 4, smem, wv); }
    }
    p0_fill_w8(p, smem, wv);
    __syncthreads();
    for (int it = bid; it < 4096; it += nb) p0_rows(p, it, smem, wv);
    __syncthreads();
  }
  if (ONLY < 0) GRID_SYNC();
  if (ONLY < 0 || ONLY == 1) {
    for (int rep = 0; rep < REP_G1; ++rep)
    for (int it = bid; it < 4096; it += nb)
      gemm_tile<1>(p, (const u16*)(p.ws + OFF_HB), (const u16*)(p.ws + OFF_WTIN), (it >> 5) * 128, (it & 31) * 128, smem, wv);
  }
  if (ONLY < 0) GRID_SYNC();
  if (ONLY < 0 || ONLY == 2) {
    for (int l = bid >> 3; l < 128; l += (nb >> 3)) p2_prep(p, (bid & 7) * 128 + l, smem, wv, (l + (nb >> 3) < 128) ? (bid & 7) * 128 + l + (nb >> 3) : -1);
#if REP_PREP > 1
    for (int it = bid; it < 1024; it += nb) p2_prep(p, it, smem, wv, -1);
#endif
  }
  if (ONLY < 0) GRID_SYNC();
  if (ONLY < 0 || ONLY == 3) {
    const int lane = lane_id();
    const float s1 = wave_sum(p.lq1[lane] * p.lk1[lane]), s2 = wave_sum(p.lq2[lane] * p.lk2[lane]);
    if (wv == 0 && lane == 0) *(float*)(smem + 73744) = __expf(s1) - __expf(s2) + 0.2f;
    __syncthreads();
    if (bid < 32) p3_scan(p, (bid & 7) * 4 + (bid >> 3), smem, wv);
    int* slot = (int*)(smem + 73728);
    const int xcc = bid & 7;
    for (int qi = 0; qi < 8; ++qi) {
      const int qx = (xcc + qi) & 7;
      unsigned* ctr = (unsigned*)(p.ws + OFF_CTR) + qx * 16;
      while (true) {
        if (wv == 0 && lane == 0) *slot = (int)atomicAdd(ctr, 1u);
        __syncthreads();
        const int it = *slot;
        __syncthreads();
        if (it >= 256) break;
        if (it < 128) {
          p3_attn(p, qx * 4 + (it & 3), 31 - (it >> 2), smem, wv);
        } else {
          const int bh = qx * 4 + (it & 3);
          if (wv == 0 && lane == 0) {
            unsigned* fl = (unsigned*)(p.ws + OFF_CTR) + 128 + bh;
            while (__hip_atomic_load(fl, __ATOMIC_RELAXED, __HIP_MEMORY_SCOPE_AGENT) == 0u) __builtin_amdgcn_s_sleep(2);
            __builtin_amdgcn_fence(__ATOMIC_ACQUIRE, "agent");
            asm volatile("s_waitcnt vmcnt(0)" ::: "memory");
          }
          __syncthreads();
          p4_dnout(p, bh * 32 + ((it - 128) >> 2), smem, wv);
        }
      }
    }
  }
  if (ONLY < 0) GRID_SYNC();
  if (ONLY < 0 || ONLY == 5) {
    for (int it = bid; it < 1024; it += nb) {
      const int xq = it & 7, s = it >> 3;
      gemm_tile<2>(p, (const u16*)(p.ws + OFF_HB), (const u16*)(p.ws + OFF_WTOUT), (xq * 16 + (s >> 3)) * 128, (s & 7) * 128, smem, wv);
    }
  }
}

extern "C" void kernel_launch(void* const* d_in, const int* in_sizes, int n_in, void* d_out, int out_size, void* d_ws, size_t ws_size,
                              hipStream_t stream) {
  Params p{};
  p.x = (const float*)d_in[0]; p.norm_gain = (const float*)d_in[1]; p.w_in = (const float*)d_in[2]; p.conv_w = (const float*)d_in[3];
  p.a_log = (const float*)d_in[4]; p.dt_bias = (const float*)d_in[5]; p.dn_out_gain = (const float*)d_in[6]; p.q_gain = (const float*)d_in[7];
  p.k_gain = (const float*)d_in[8]; p.lq1 = (const float*)d_in[9]; p.lk1 = (const float*)d_in[10]; p.lq2 = (const float*)d_in[11];
  p.lk2 = (const float*)d_in[12]; p.df_out_gain = (const float*)d_in[13]; p.w_out = (const float*)d_in[14];
  p.out = (float*)d_out; p.ws = (unsigned char*)d_ws;
  static int grid_blocks = 0;
  if (!grid_blocks) {
    int dev = 0, cus = 0, per_cu = 0;
    (void)hipGetDevice(&dev);
    (void)hipDeviceGetAttribute(&cus, hipDeviceAttributeMultiprocessorCount, dev);
#if USE_COOP
    (void)hipOccupancyMaxActiveBlocksPerMultiprocessor(&per_cu, fwd_kernel<-1>, 256, 0);
#else
    per_cu = 2;
#endif
    if (per_cu > 2) per_cu = 2;
    if (per_cu < 1) per_cu = 1;
    grid_blocks = cus * per_cu;
  }
#if USE_COOP
  (void)hipMemsetAsync((unsigned char*)d_ws + OFF_BAR, 0, 3456 * 4, stream);
  p.phase_lo = 0; p.phase_hi = 5; p.coop = 1;
  void* args[] = {&p};
  hipError_t e = hipLaunchCooperativeKernel((void*)fwd_kernel<-1>, dim3(grid_blocks), dim3(256), args, 0, stream);
  if (e != hipSuccess) fprintf(stderr, "cooperative launch failed: %s (grid %d)\n", hipGetErrorString(e), grid_blocks);
#else
  p.coop = 0;
  p.phase_lo = 0; p.phase_hi = 1; hipLaunchKernelGGL(fwd_kernel<0>, dim3(grid_blocks), dim3(256), 0, stream, p);
  p.phase_lo = 1; p.phase_hi = 2; hipLaunchKernelGGL(fwd_kernel<1>, dim3(grid_blocks), dim3(256), 0, stream, p);
  p.phase_lo = 2; p.phase_hi = 3; hipLaunchKernelGGL(fwd_kernel<2>, dim3(grid_blocks), dim3(256), 0, stream, p);
  p.phase_lo = 3; p.phase_hi = 4; hipLaunchKernelGGL(fwd_kernel<3>, dim3(grid_blocks), dim3(256), 0, stream, p);
  p.phase_lo = 4; p.phase_hi = 5; hipLaunchKernelGGL(fwd_kernel<4>, dim3(grid_blocks), dim3(256), 0, stream, p);
  p.phase_lo = 5; p.phase_hi = 6; hipLaunchKernelGGL(fwd_kernel<5>, dim3(grid_blocks), dim3(256), 0, stream, p);
#endif
}
```

```cpp
#include <hip/hip_runtime.h>
#include <hip/hip_cooperative_groups.h>
#include <cstdio>
#include <cstdint>
namespace cg = cooperative_groups;

#ifndef REP_P0
#define REP_P0 1
#endif
#ifndef REP_DNOUT
#define REP_DNOUT 1
#endif
#ifndef REP_G1
#define REP_G1 1
#endif
#ifndef REP_PREP
#define REP_PREP 1
#endif
#ifndef REP_SCAN
#define REP_SCAN 1
#endif
#ifndef REP_ATTN
#define REP_ATTN 1
#endif
#ifndef USE_COOP
#define USE_COOP 1
#endif

#define DI __device__ __forceinline__
typedef __attribute__((ext_vector_type(8))) short bf16x8;
typedef __attribute__((ext_vector_type(4))) short s16x4;
typedef __attribute__((ext_vector_type(4))) float f32x4;
typedef short v4i16_t __attribute__((ext_vector_type(4)));
typedef __attribute__((address_space(3))) const char* lds_cptr;
typedef unsigned short u16;

constexpr int SEQ = 2048, NTOK = 16384, DMODEL = 1024, NP = 4096, WIN_LD = 4104;
constexpr int C_DNQ = 0, C_DNK = 512, C_DNV = 1024, C_DNZ = 1536, C_DFQ = 2048, C_DFK = 2560, C_DFV = 3072, C_DFZ = 3584;
constexpr float EPSV = 1e-6f;
constexpr float LOG2E = 1.4426950408889634f;

constexpr size_t OFF_PROJ = 0;
constexpr size_t OFF_HB = 134217728;
constexpr size_t OFF_WTIN = OFF_HB + 33554432;
constexpr size_t OFF_WTOUT = OFF_WTIN + 8388608;
constexpr size_t OFF_G = OFF_WTOUT + 2097152;
constexpr size_t OFF_BETA = OFF_G + 262144;
constexpr size_t OFF_DN = OFF_BETA + 262144;
constexpr size_t DN_CHUNK_B = 73728;
constexpr size_t DN_NEGW = 0, DN_QG = 16384, DN_KD = 32768, DN_A = 49152, DN_U = 57344;
constexpr size_t OFF_GLAST = OFF_DN + DN_CHUNK_B * 1024;
constexpr size_t OFF_CTR = OFF_GLAST + 4096;
constexpr size_t OFF_BAR = OFF_CTR + 1024;

constexpr int SMEM_BYTES = 77824;

struct Params {
  const float *x, *norm_gain, *w_in, *conv_w, *a_log, *dt_bias, *dn_out_gain, *q_gain, *k_gain;
  const float *lq1, *lk1, *lq2, *lk2, *df_out_gain, *w_out;
  float* out;
  unsigned char* ws;
  int phase_lo, phase_hi, coop, pad0;
};

typedef __bf16 bf16x2_t __attribute__((ext_vector_type(2)));
DI unsigned cvtpk(float lo, float hi) { bf16x2_t v; v[0] = (__bf16)lo; v[1] = (__bf16)hi; return __builtin_bit_cast(unsigned, v); }
DI float bf2f(u16 h) { return __uint_as_float(((unsigned)h) << 16); }
DI float bflo(unsigned u) { return __uint_as_float(u << 16); }
DI float bfhi(unsigned u) { return __uint_as_float(u & 0xffff0000u); }
DI u16 f2bf(float x) { return (u16)(cvtpk(x, 0.f) & 0xffffu); }
template <int X> DI float lx(float v) { return __builtin_bit_cast(float, __builtin_amdgcn_ds_swizzle(__builtin_bit_cast(int, v), 0x1f | (X << 10))); }
DI float lx32_sum(float v) { auto rr = __builtin_amdgcn_permlane32_swap(__float_as_uint(v), __float_as_uint(v), false, false); return __uint_as_float(rr[0]) + __uint_as_float(rr[1]); }
DI float lx32_max(float v) { auto rr = __builtin_amdgcn_permlane32_swap(__float_as_uint(v), __float_as_uint(v), false, false); return fmaxf(__uint_as_float(rr[0]), __uint_as_float(rr[1])); }
DI float wave_sum(float v) {
  v += lx<1>(v); v += lx<2>(v); v += lx<4>(v); v += lx<8>(v); v += lx<16>(v);
  return lx32_sum(v);
}
DI int lane_id() { int l; asm volatile("v_mbcnt_lo_u32_b32 %0, -1, 0\n\tv_mbcnt_hi_u32_b32 %0, -1, %0" : "=v"(l)); return l; }
DI float silu_f(float y) { return y * __builtin_amdgcn_rcpf(1.f + __expf(-y)); }
DI s16x4 vtr(const char* p) { return __builtin_bit_cast(s16x4, __builtin_amdgcn_ds_read_tr16_b64_v4i16((__attribute__((address_space(3))) v4i16_t*)(lds_cptr)p)); }
#define MFMA16(a, b, c) __builtin_amdgcn_mfma_f32_16x16x32_bf16((a), (b), (c), 0, 0, 0)
DI bf16x8 pack8(const f32x4& a, const f32x4& b) {
  uint4 u; u.x = cvtpk(a[0], a[1]); u.y = cvtpk(a[2], a[3]); u.z = cvtpk(b[0], b[1]); u.w = cvtpk(b[2], b[3]);
  return __builtin_bit_cast(bf16x8, u);
}

DI void p0_fill_w8(const Params& p, char* smem, int wv) {
  int tid_ = (wv << 6) | lane_id(); asm volatile("" : "+v"(tid_)); const int tid = tid_;
  float4* pl = (float4*)smem;
#pragma unroll
  for (int j = 0; j < 8; ++j) {
    const int q = tid + 256 * j, k = q >> 1, c4 = q & 1;
    pl[(c4 * 4 + (k & 3)) * 256 + (k >> 2)] = *(const float4*)(p.w_in + (size_t)k * WIN_LD + 2048 + 4 * c4);
  }
}
DI void p0_rows(const Params& p, int item, char* smem, int wv) {
  int tid_ = (wv << 6) | lane_id(); asm volatile("" : "+v"(tid_)); const int tid = tid_, wave = tid >> 6, lane = tid & 63;
  const int row = item * 4 + wave;
  const float4* pl = (const float4*)smem;
  const float4* xr = (const float4*)(p.x + (size_t)row * 1024);
  float4 xv[4]; float ss = 0.f;
  float acc[8];
#pragma unroll
  for (int j = 0; j < 8; ++j) acc[j] = 0.f;
#pragma unroll
  for (int i = 0; i < 4; ++i) {
    { const f32x4 t4 = __builtin_nontemporal_load((const f32x4*)xr + lane + 64 * i); xv[i] = make_float4(t4[0], t4[1], t4[2], t4[3]); }
    const float4 g = ((const float4*)p.norm_gain)[lane + 64 * i];
    ss += xv[i].x * xv[i].x + xv[i].y * xv[i].y + xv[i].z * xv[i].z + xv[i].w * xv[i].w;
    xv[i].x *= g.x; xv[i].y *= g.y; xv[i].z *= g.z; xv[i].w *= g.w;
    const float hh[4] = {xv[i].x, xv[i].y, xv[i].z, xv[i].w};
#pragma unroll
    for (int e = 0; e < 4; ++e) {
      const float4 w0 = pl[(0 + e) * 256 + lane + 64 * i], w1 = pl[(4 + e) * 256 + lane + 64 * i];
      acc[0] += hh[e] * w0.x; acc[1] += hh[e] * w0.y; acc[2] += hh[e] * w0.z; acc[3] += hh[e] * w0.w;
      acc[4] += hh[e] * w1.x; acc[5] += hh[e] * w1.y; acc[6] += hh[e] * w1.z; acc[7] += hh[e] * w1.w;
    }
  }
  ss = wave_sum(ss);
#pragma unroll
  for (int j = 0; j < 8; ++j) acc[j] = wave_sum(acc[j]);
  const float rstd = rsqrtf(ss * (1.f / 1024.f) + EPSV);
  u16* hb = (u16*)(p.ws + OFF_HB);
#pragma unroll
  for (int i = 0; i < 4; ++i) {
    uint2 pk; pk.x = cvtpk(xv[i].x * rstd, xv[i].y * rstd); pk.y = cvtpk(xv[i].z * rstd, xv[i].w * rstd);
    *(uint2*)(hb + (size_t)row * 1024 + (lane + 64 * i) * 4) = pk;
  }
  if (lane < 8) {
    float v = acc[0];
    v = lane == 1 ? acc[1] : v; v = lane == 2 ? acc[2] : v; v = lane == 3 ? acc[3] : v;
    v = lane == 4 ? acc[4] : v; v = lane == 5 ? acc[5] : v; v = lane == 6 ? acc[6] : v; v = lane == 7 ? acc[7] : v;
    v *= rstd;
    const int hd = lane & 3;
    if (lane < 4) {
      ((float*)(p.ws + OFF_BETA))[row * 4 + hd] = 1.f / (1.f + expf(-v));
    } else {
      const float a = v + p.dt_bias[hd];
      const float sp = fmaxf(a, 0.f) + log1pf(expf(-fabsf(a)));
      ((float*)(p.ws + OFF_G))[row * 4 + hd] = -expf(p.a_log[hd]) * sp;
    }
  }
}

DI void p0_transpose(const float* __restrict__ W, int ldw, bool is_win, u16* __restrict__ Wt, int kt, int nt, char* smem, int wv) {
  float* tile = (float*)smem;
  int tid_ = (wv << 6) | lane_id(); asm volatile("" : "+v"(tid_)); const int tid = tid_;
  const int c = tid & 63;
  const int n = nt * 64 + c;
  const int col = n + ((is_win && n >= 2048) ? 8 : 0);
#pragma unroll
  for (int i = 0; i < 16; ++i) {
    const int r = (tid >> 6) + 4 * i;
    tile[r * 65 + c] = __builtin_nontemporal_load(W + (size_t)(kt * 64 + r) * ldw + col);
  }
  __syncthreads();
  const int nn = tid >> 2, kp = (tid & 3) * 16;
  unsigned pk[8];
#pragma unroll
  for (int e = 0; e < 8; ++e) pk[e] = cvtpk(tile[(kp + 2 * e) * 65 + nn], tile[(kp + 2 * e + 1) * 65 + nn]);
  uint4* dst = (uint4*)(Wt + (size_t)(nt * 64 + nn) * 1024 + kt * 64 + kp);
  dst[0] = make_uint4(pk[0], pk[1], pk[2], pk[3]);
  dst[1] = make_uint4(pk[4], pk[5], pk[6], pk[7]);
  __syncthreads();
}

template <int EPI>
DI void gemm_tile(const Params& p, const u16* __restrict__ A, const u16* __restrict__ Bt, int m0, int n0, char* smem, int wv) {
  constexpr int K = 1024, NKT = K / 64;
  int tid_ = (wv << 6) | lane_id(); asm volatile("" : "+v"(tid_)); const int tid = tid_, wave = tid >> 6, lane = tid & 63, fr = lane & 15, fq = lane >> 4, wr = wave >> 1, wc = wave & 1;
  f32x4 acc[4][4];
#pragma unroll
  for (int i = 0; i < 4; ++i)
#pragma unroll
    for (int j = 0; j < 4; ++j) acc[i][j] = f32x4{0.f, 0.f, 0.f, 0.f};
  float4 xin[4][4];
  if (EPI == 2) {
#pragma unroll
    for (int mt = 0; mt < 4; ++mt)
#pragma unroll
      for (int nt = 0; nt < 4; ++nt)
        { const f32x4 t4 = __builtin_nontemporal_load((const f32x4*)(p.x + (size_t)(m0 + wr * 64 + mt * 16 + fr) * 1024 + n0 + wc * 64 + nt * 16 + 4 * fq));
          xin[mt][nt] = make_float4(t4[0], t4[1], t4[2], t4[3]); }
  }
  char* As = smem; char* Bs = smem + 32768;
  const int srow = tid >> 3, sc8 = (tid & 7) ^ ((tid >> 4) & 7);
  const u16* ag = A + (size_t)(m0 + srow) * K + sc8 * 8;
  const u16* bg = Bt + (size_t)(n0 + srow) * K + sc8 * 8;
#define G_GLDS(nb_, kt_) { _Pragma("unroll") for (int i = 0; i < 4; ++i) { \
    __builtin_amdgcn_global_load_lds((const unsigned*)(ag + (size_t)(32 * i) * K + (kt_) * 64), (unsigned*)(As + (nb_) + wv * 1024 + i * 4096), 16, 0, 0); \
    __builtin_amdgcn_global_load_lds((const unsigned*)(bg + (size_t)(32 * i) * K + (kt_) * 64), (unsigned*)(Bs + (nb_) + wv * 1024 + i * 4096), 16, 0, 0); } }
  G_GLDS(0, 0);
  __syncthreads();
  const int fsw = fr >> 1;
  for (int kt = 0; kt < NKT; ++kt) {
    const int buf = (kt & 1) * 16384;
    if (kt + 1 < NKT) G_GLDS(((kt + 1) & 1) * 16384, kt + 1);
#pragma unroll
    for (int ks = 0; ks < 2; ++ks) {
      bf16x8 af[4], bfr[4];
      const int sw = ((ks * 4 + fq) ^ fsw) << 4;
#pragma unroll
      for (int mt = 0; mt < 4; ++mt) af[mt] = *(const bf16x8*)(As + buf + (wr * 64 + mt * 16 + fr) * 128 + sw);
#pragma unroll
      for (int nt = 0; nt < 4; ++nt) bfr[nt] = *(const bf16x8*)(Bs + buf + (wc * 64 + nt * 16 + fr) * 128 + sw);
#pragma unroll
      for (int mt = 0; mt < 4; ++mt)
#pragma unroll
        for (int nt = 0; nt < 4; ++nt) acc[mt][nt] = MFMA16(bfr[nt], af[mt], acc[mt][nt]);
    }
    __syncthreads();
  }
  float qsc[4]; float4 qg4[4];
#pragma unroll
  for (int i = 0; i < 4; ++i) { qsc[i] = 1.f; qg4[i] = make_float4(1.f, 1.f, 1.f, 1.f); }
  if (EPI == 1 && n0 >= C_DFQ && n0 < C_DFV) {
    const bool isq = n0 < C_DFK;
    const float* gp = isq ? p.q_gain : p.k_gain;
#pragma unroll
    for (int nt = 0; nt < 4; ++nt) qg4[nt] = *(const float4*)(gp + nt * 16 + 4 * fq);
#pragma unroll
    for (int mt = 0; mt < 4; ++mt) {
      float ss = 0.f;
#pragma unroll
      for (int nt = 0; nt < 4; ++nt) ss += acc[mt][nt][0] * acc[mt][nt][0] + acc[mt][nt][1] * acc[mt][nt][1] + acc[mt][nt][2] * acc[mt][nt][2] + acc[mt][nt][3] * acc[mt][nt][3];
      ss += lx<16>(ss); ss = lx32_sum(ss);
      qsc[mt] = rsqrtf(ss * (1.f / 64.f) + EPSV) * (isq ? 0.125f * LOG2E : 1.f);
    }
  }
#pragma unroll
  for (int mt = 0; mt < 4; ++mt) {
    const int m = m0 + wr * 64 + mt * 16 + fr;
#pragma unroll
    for (int nt = 0; nt < 4; ++nt) {
      const int n = n0 + wc * 64 + nt * 16 + 4 * fq;
      if (EPI == 1) {
        u16* proj = (u16*)(p.ws + OFF_PROJ);
        uint2 pk; pk.x = cvtpk(acc[mt][nt][0] * qsc[mt] * qg4[nt].x, acc[mt][nt][1] * qsc[mt] * qg4[nt].y);
        pk.y = cvtpk(acc[mt][nt][2] * qsc[mt] * qg4[nt].z, acc[mt][nt][3] * qsc[mt] * qg4[nt].w);
        *(uint2*)(proj + (size_t)m * NP + n) = pk;
      } else {
        const float4 xi = xin[mt][nt];
        float4 o; o.x = xi.x + acc[mt][nt][0]; o.y = xi.y + acc[mt][nt][1]; o.z = xi.z + acc[mt][nt][2]; o.w = xi.w + acc[mt][nt][3];
        *(float4*)(p.out + (size_t)m * 1024 + n) = o;
      }
    }
  }
}

DI void p2_qknorm(const Params& p, int item, int wv) {
  int tid_ = (wv << 6) | lane_id(); asm volatile("" : "+v"(tid_)); const int tid = tid_, wave = tid >> 6, lane = tid & 63;
  const int row = item * 4 + wave;
  u16* pr = (u16*)(p.ws + OFF_PROJ) + (size_t)row * NP + C_DFQ + lane * 16;
  uint4 v0 = ((const uint4*)pr)[0], v1 = ((const uint4*)pr)[1];
  unsigned w[8] = {v0.x, v0.y, v0.z, v0.w, v1.x, v1.y, v1.z, v1.w};
  float f[16]; float ss = 0.f;
#pragma unroll
  for (int e = 0; e < 8; ++e) { f[2 * e] = bflo(w[e]); f[2 * e + 1] = bfhi(w[e]); ss += f[2 * e] * f[2 * e] + f[2 * e + 1] * f[2 * e + 1]; }
  ss += lx<1>(ss); ss += lx<2>(ss);
  const float rstd = rsqrtf(ss * (1.f / 64.f) + EPSV);
  const bool isq = lane < 32;
  const float* gp = (isq ? p.q_gain : p.k_gain) + (lane & 3) * 16;
  const float sc = rstd * (isq ? 0.125f * LOG2E : 1.f);
  unsigned o[8];
#pragma unroll
  for (int e = 0; e < 8; ++e) o[e] = cvtpk(f[2 * e] * sc * gp[2 * e], f[2 * e + 1] * sc * gp[2 * e + 1]);
  ((uint4*)pr)[0] = make_uint4(o[0], o[1], o[2], o[3]);
  ((uint4*)pr)[1] = make_uint4(o[4], o[5], o[6], o[7]);
}

DI void p2_prep(const Params& p, int item, char* smem, int wv) {
  int tid_ = (wv << 6) | lane_id(); asm volatile("" : "+v"(tid_)); const int tid = tid_, wave = tid >> 6, lane = tid & 63, fr = lane & 15, fq = lane >> 4;
  const int n = item & 31, h = (item >> 5) & 3, b = item >> 7;
  u16* qn = (u16*)smem;
  u16* kn = (u16*)(smem + 17408);
  u16* vb = (u16*)(smem + 34816);
  u16* Mb = (u16*)(smem + 51200);
  float* Md = (float*)(smem + 59392);
  u16* Dv = (u16*)(smem + 63488);
  u16* Asm = (u16*)(smem + 67584);
  float* gcs = (float*)(smem + 75776);
  float* bts = gcs + 64;
  float* egs = bts + 64;
  float* kds = egs + 64;
  const size_t tok0 = (size_t)b * SEQ + n * 64;
  const u16* proj = (const u16*)(p.ws + OFF_PROJ);
  unsigned char* dnb = p.ws + OFF_DN + (size_t)item * DN_CHUNK_B;

  if (wave == 0) {
    egs[lane] = ((const float*)(p.ws + OFF_G))[(tok0 + lane) * 4 + h];
    float gv = 0.f;
    for (int i = 0; i < 64; ++i) { const float t = egs[i]; gv += (i <= lane) ? t : 0.f; }
    gcs[lane] = gv;
    bts[lane] = ((const float*)(p.ws + OFF_BETA))[(tok0 + lane) * 4 + h];
    egs[lane] = __expf(gv);
    kds[lane] = __expf(__uint_as_float(__builtin_amdgcn_readlane(__float_as_uint(gv), 63)) - gv);
    if (lane == 63) ((float*)(p.ws + OFF_GLAST))[item] = gv;
  }
  {
    const int t0 = wave * 16;
    const u16* pcol = proj + h * 128 + 2 * lane;
    unsigned uq[19], uk[19], uv[19];
#pragma unroll
    for (int j = 0; j < 19; ++j) {
      const int tt = n * 64 + t0 - 3 + j;
      uq[j] = 0u; uk[j] = 0u; uv[j] = 0u;
      if (tt >= 0) {
        const u16* pp = pcol + ((size_t)b * SEQ + tt) * NP;
        uq[j] = __builtin_nontemporal_load((const unsigned*)(pp + C_DNQ)); uk[j] = __builtin_nontemporal_load((const unsigned*)(pp + C_DNK)); uv[j] = __builtin_nontemporal_load((const unsigned*)(pp + C_DNV));
      }
    }
    float2 cwq[4], cwk[4], cwv[4];
#pragma unroll
    for (int j = 0; j < 4; ++j) {
      cwq[j] = *(const float2*)(p.conv_w + j * 1536 + h * 128 + 2 * lane);
      cwk[j] = *(const float2*)(p.conv_w + j * 1536 + 512 + h * 128 + 2 * lane);
      cwv[j] = *(const float2*)(p.conv_w + j * 1536 + 1024 + h * 128 + 2 * lane);
    }
    asm volatile("" ::: "memory");
    float yqx[16], yqy[16], ykx[16], yky[16], sq[16], sk[16];
#pragma unroll
    for (int tt = 0; tt < 16; ++tt) {
      float ax = 0.f, ay = 0.f, bx = 0.f, by = 0.f, cx = 0.f, cy = 0.f;
#pragma unroll
      for (int j = 0; j < 4; ++j) {
        ax += cwq[j].x * bflo(uq[tt + j]); ay += cwq[j].y * bfhi(uq[tt + j]);
        bx += cwk[j].x * bflo(uk[tt + j]); by += cwk[j].y * bfhi(uk[tt + j]);
        cx += cwv[j].x * bflo(uv[tt + j]); cy += cwv[j].y * bfhi(uv[tt + j]);
      }
      ax = silu_f(ax); ay = silu_f(ay); bx = silu_f(bx); by = silu_f(by); cx = silu_f(cx); cy = silu_f(cy);
      yqx[tt] = ax; yqy[tt] = ay; ykx[tt] = bx; yky[tt] = by;
      sq[tt] = ax * ax + ay * ay; sk[tt] = bx * bx + by * by;
      *(unsigned*)(vb + (t0 + tt) * 128 + 2 * lane) = cvtpk(cx, cy);
    }
#define RED_STEP(X) { _Pragma("unroll") for (int tt = 0; tt < 16; ++tt) { sq[tt] += lx<X>(sq[tt]); sk[tt] += lx<X>(sk[tt]); } }
    RED_STEP(1) RED_STEP(2) RED_STEP(4) RED_STEP(8) RED_STEP(16)
#pragma unroll
    for (int tt = 0; tt < 16; ++tt) {
      const float rq = rsqrtf(lx32_sum(sq[tt]) + EPSV) * 0.08838834764831845f;
      const float rk = rsqrtf(lx32_sum(sk[tt]) + EPSV);
      *(unsigned*)(qn + (t0 + tt) * 136 + 2 * lane) = cvtpk(yqx[tt] * rq, yqy[tt] * rq);
      *(unsigned*)(kn + (t0 + tt) * 136 + 2 * lane) = cvtpk(ykx[tt] * rk, yky[tt] * rk);
    }
  }
  __syncthreads();
  {
    f32x4 akk[4], aqk[4];
#pragma unroll
    for (int i = 0; i < 4; ++i) { akk[i] = f32x4{0.f, 0.f, 0.f, 0.f}; aqk[i] = f32x4{0.f, 0.f, 0.f, 0.f}; }
#pragma unroll
    for (int ks = 0; ks < 4; ++ks) {
      const bf16x8 ak = *(const bf16x8*)((const char*)kn + (16 * wave + fr) * 272 + (32 * ks + 8 * fq) * 2);
      const bf16x8 aq = *(const bf16x8*)((const char*)qn + (16 * wave + fr) * 272 + (32 * ks + 8 * fq) * 2);
#pragma unroll
      for (int nt = 0; nt < 4; ++nt) {
        if (nt <= wave) {
          const bf16x8 bk = *(const bf16x8*)((const char*)kn + (16 * nt + fr) * 272 + (32 * ks + 8 * fq) * 2);
          akk[nt] = MFMA16(ak, bk, akk[nt]);
          aqk[nt] = MFMA16(aq, bk, aqk[nt]);
        }
      }
    }
#pragma unroll
    for (int nt = 0; nt < 4; ++nt)
#pragma unroll
      for (int j = 0; j < 4; ++j) {
        const int c = 16 * wave + 4 * fq + j, s = 16 * nt + fr;
        const float dec = (s <= c) ? __expf(gcs[c] - gcs[s]) : 0.f;
        const float mv = (s < c) ? bts[c] * akk[nt][j] * dec : 0.f;
        Mb[c * 64 + s] = f2bf(-mv);
        if (nt == wave) Md[wave * 256 + (c & 15) * 16 + (s & 15)] = mv;
        Asm[c * 64 + s] = f2bf((s <= c) ? aqk[nt][j] * dec : 0.f);
      }
    {
      const float* md = Md + wave * 256;
      float t[16];
#pragma unroll
      for (int i = 0; i < 16; ++i) t[i] = (i == lane) ? 1.f : 0.f;
#pragma unroll
      for (int j = 0; j < 15; ++j)
#pragma unroll
        for (int i = j + 1; i < 16; ++i) t[i] -= md[i * 16 + j] * t[j];
      if (lane < 16) {
#pragma unroll
        for (int i = 0; i < 16; ++i) Dv[wave * 256 + i * 16 + lane] = f2bf(t[i]);
      }
    }
  }
  __syncthreads();
  {
    const float glast = gcs[63];
#pragma unroll
    for (int it = 0; it < 4; ++it) {
      const int pp = tid + 256 * it;
      const int frag = pp >> 6, l2 = pp & 63, m = l2 & 15, qq = l2 >> 4;
      {
        const int mt = frag >> 2, ks = frag & 3, row = 16 * mt + m;
        const uint2 lo = *(const uint2*)((const char*)qn + row * 272 + (32 * ks + 4 * qq) * 2);
        const uint2 hi = *(const uint2*)((const char*)qn + row * 272 + (32 * ks + 16 + 4 * qq) * 2);
        const float e = egs[row];
        uint4 o;
        o.x = cvtpk(bflo(lo.x) * e, bfhi(lo.x) * e); o.y = cvtpk(bflo(lo.y) * e, bfhi(lo.y) * e);
        o.z = cvtpk(bflo(hi.x) * e, bfhi(hi.x) * e); o.w = cvtpk(bflo(hi.y) * e, bfhi(hi.y) * e);
        *(uint4*)(dnb + DN_QG + (size_t)pp * 16) = o;
      }
      {
        const int mtk = frag >> 1, ks = frag & 1, dk = 16 * mtk + m;
        float v[8];
#pragma unroll
        for (int j = 0; j < 8; ++j) {
          const int c = 32 * ks + ((j >> 2) << 4) + 4 * qq + (j & 3);
          v[j] = bf2f(kn[c * 136 + dk]) * kds[c];
        }
        uint4 o; o.x = cvtpk(v[0], v[1]); o.y = cvtpk(v[2], v[3]); o.z = cvtpk(v[4], v[5]); o.w = cvtpk(v[6], v[7]);
        *(uint4*)(dnb + DN_KD + (size_t)pp * 16) = o;
      }
      if (it < 2) {
        const int mt = frag >> 1, ks = frag & 1, row = 16 * mt + m;
        const uint2 lo = *(const uint2*)((const char*)Asm + row * 128 + (32 * ks + 4 * qq) * 2);
        const uint2 hi = *(const uint2*)((const char*)Asm + row * 128 + (32 * ks + 16 + 4 * qq) * 2);
        *(uint4*)(dnb + DN_A + (size_t)pp * 16) = make_uint4(lo.x, lo.y, hi.x, hi.y);
      }
    }
  }
  const bool isv = wave < 2;
  f32x4 Xs[4][4];
  {
    const f32x4 z4 = f32x4{0.f, 0.f, 0.f, 0.f};
    bf16x8 dinv[4], m10, m20, m30, m31;
#pragma unroll
    for (int I = 0; I < 4; ++I) {
      const uint2 lo = *(const uint2*)(Dv + I * 256 + fr * 16 + 4 * fq);
      dinv[I] = __builtin_bit_cast(bf16x8, make_uint4(lo.x, lo.y, 0u, 0u));
    }
#define MBFRAG(I_, P_) __builtin_bit_cast(bf16x8, make_uint4(((const uint2*)(Mb + (16 * (I_) + fr) * 64 + 32 * (P_) + 4 * fq))->x, ((const uint2*)(Mb + (16 * (I_) + fr) * 64 + 32 * (P_) + 4 * fq))->y, \
                                                              ((const uint2*)(Mb + (16 * (I_) + fr) * 64 + 32 * (P_) + 16 + 4 * fq))->x, ((const uint2*)(Mb + (16 * (I_) + fr) * 64 + 32 * (P_) + 16 + 4 * fq))->y))
    m10 = MBFRAG(1, 0); m20 = MBFRAG(2, 0); m30 = MBFRAG(3, 0); m31 = MBFRAG(3, 1);
#pragma unroll
    for (int nt = 0; nt < 4; ++nt) {
      const int colx = (64 * wave + 16 * nt + fr) & 127;
      const u16* srcp = isv ? (vb + colx) : (kn + colx);
      const int sst = isv ? 128 : 136;
      f32x4 R[4];
#pragma unroll
      for (int I = 0; I < 4; ++I)
#pragma unroll
        for (int j = 0; j < 4; ++j) {
          const int row = 16 * I + 4 * fq + j;
          R[I][j] = bf2f(srcp[row * sst]) * bts[row] * (isv ? 1.f : egs[row]);
        }
      const f32x4 X0 = MFMA16(dinv[0], pack8(R[0], z4), z4);
      const f32x4 Y1 = MFMA16(m10, pack8(X0, z4), R[1]);
      const f32x4 X1 = MFMA16(dinv[1], pack8(Y1, z4), z4);
      const bf16x8 x01 = pack8(X0, X1);
      const f32x4 Y2 = MFMA16(m20, x01, R[2]);
      const f32x4 X2 = MFMA16(dinv[2], pack8(Y2, z4), z4);
      f32x4 Y3 = MFMA16(m30, x01, R[3]);
      Y3 = MFMA16(m31, pack8(X2, z4), Y3);
      const f32x4 X3 = MFMA16(dinv[3], pack8(Y3, z4), z4);
      Xs[nt][0] = X0; Xs[nt][1] = X1; Xs[nt][2] = X2; Xs[nt][3] = X3;
    }
  }
  if (isv) {
#pragma unroll
    for (int nt = 0; nt < 4; ++nt)
#pragma unroll
      for (int I = 0; I < 4; ++I) {
        uint2 o; o.x = cvtpk(Xs[nt][I][0], Xs[nt][I][1]); o.y = cvtpk(Xs[nt][I][2], Xs[nt][I][3]);
        *(uint2*)(dnb + DN_U + (size_t)(((I * 8 + 4 * wave + nt) * 64 + lane) * 8)) = o;
      }
  }
  __syncthreads();
  if (!isv) {
#pragma unroll
    for (int nt = 0; nt < 4; ++nt) {
      const int colx = (64 * wave + 16 * nt + fr) & 127;
#pragma unroll
      for (int I = 0; I < 4; ++I)
#pragma unroll
        for (int j = 0; j < 4; ++j) qn[(16 * I + 4 * fq + j) * 136 + colx] = f2bf(-Xs[nt][I][j]);
    }
  }
  __syncthreads();
#pragma unroll
  for (int it = 0; it < 4; ++it) {
    const int pp = tid + 256 * it;
    const int frag = pp >> 6, l2 = pp & 63, m = l2 & 15, qq = l2 >> 4;
    const int mt = frag >> 2, ks = frag & 3, row = 16 * mt + m;
    const uint2 lo = *(const uint2*)((const char*)qn + row * 272 + (32 * ks + 4 * qq) * 2);
    const uint2 hi = *(const uint2*)((const char*)qn + row * 272 + (32 * ks + 16 + 4 * qq) * 2);
    *(uint4*)(dnb + DN_NEGW + (size_t)pp * 16) = make_uint4(lo.x, lo.y, hi.x, hi.y);
  }
  __syncthreads();
}

constexpr size_t OUT_SN = 0;
constexpr size_t OUT_VN = 33554432;
DI void p3_scan(const Params& p, int bh, char* smem, int wv) {
  int tid_ = (wv << 6) | lane_id(); asm volatile("" : "+v"(tid_)); const int tid = tid_, wave = tid >> 6, lane = tid & 63;
  f32x4 S[8][2]; bf16x8 Sb[4][2];
#pragma unroll
  for (int i = 0; i < 8; ++i) { S[i][0] = f32x4{0.f, 0.f, 0.f, 0.f}; S[i][1] = f32x4{0.f, 0.f, 0.f, 0.f}; }
#pragma unroll
  for (int i = 0; i < 4; ++i) { Sb[i][0] = bf16x8{0, 0, 0, 0, 0, 0, 0, 0}; Sb[i][1] = bf16x8{0, 0, 0, 0, 0, 0, 0, 0}; }
  char* L = smem;
  float* egl_s = (float*)(smem + 65536);
  const unsigned char* dn0 = p.ws + OFF_DN + (size_t)(bh * 32) * DN_CHUNK_B;
  unsigned char* sn0 = (unsigned char*)p.out + OUT_SN + (size_t)(bh * 32) * 32768;
  unsigned char* vn0 = (unsigned char*)p.out + OUT_VN + (size_t)(bh * 32) * 16384;
  if (tid < 32) egl_s[tid] = __expf(((const float*)(p.ws + OFF_GLAST))[bh * 32 + tid]);
  uint4 r0, r1, r2, r3, r4, r5, r6, r7; uint2 un[8];
#define SC_NT4(p_) __builtin_bit_cast(uint4, __builtin_nontemporal_load((const f32x4*)(p_)))
#define SC_LOADC(n_) { const uint4* a_ = (const uint4*)(dn0 + (size_t)(n_) * DN_CHUNK_B + DN_NEGW) + tid; \
                       const uint4* b_ = (const uint4*)(dn0 + (size_t)(n_) * DN_CHUNK_B + DN_KD) + tid; \
                       r0 = SC_NT4(a_); r1 = SC_NT4(a_ + 256); r2 = SC_NT4(a_ + 512); r3 = SC_NT4(a_ + 768); \
                       r4 = SC_NT4(b_); r5 = SC_NT4(b_ + 256); r6 = SC_NT4(b_ + 512); r7 = SC_NT4(b_ + 768); }
#define SC_LOADU(dst, n_) { const uint2* u_ = (const uint2*)(dn0 + (size_t)(n_) * DN_CHUNK_B + DN_U) + lane; \
                            dst[0] = u_[(0 + 2 * wave) * 64]; dst[1] = u_[(0 + 2 * wave + 1) * 64]; dst[2] = u_[(8 + 2 * wave) * 64]; dst[3] = u_[(8 + 2 * wave + 1) * 64]; \
                            dst[4] = u_[(16 + 2 * wave) * 64]; dst[5] = u_[(16 + 2 * wave + 1) * 64]; dst[6] = u_[(24 + 2 * wave) * 64]; dst[7] = u_[(24 + 2 * wave + 1) * 64]; }
#define SC_STOREL(buf) { uint4* l_ = (uint4*)(L + (buf) * 32768) + tid; \
                         l_[0] = r0; l_[256] = r1; l_[512] = r2; l_[768] = r3; l_[1024] = r4; l_[1280] = r5; l_[1536] = r6; l_[1792] = r7; }
  unsigned warm = 0u;
  const unsigned char* tbase = dn0 + (wv & 1) * 8192 + (wv >> 1) * 32768;
  const unsigned char* ubase = dn0 + DN_U + (wv & 1) * 8192;
#define SC_TOUCH(n_) { const unsigned toff_ = (unsigned)lane * 128u; \
    asm volatile("global_load_dword %0, %1, %2" : "+v"(warm) : "v"(toff_), "s"(tbase + (size_t)(n_) * DN_CHUNK_B) : "memory"); \
    asm volatile("global_load_dword %0, %1, %2" : "+v"(warm) : "v"(toff_), "s"(ubase + (size_t)(n_) * DN_CHUNK_B) : "memory"); }
  SC_TOUCH(2); SC_TOUCH(3); SC_TOUCH(4);
  SC_LOADC(0); SC_LOADU(un, 0); SC_STOREL(0);
  __syncthreads();
  SC_LOADC(1);
  for (int n = 0; n < 32; ++n) {
    const char* B = L + (n & 1) * 32768 + lane * 16;
    if (n + 5 < 32) SC_TOUCH(n + 5);
    f32x4 av[4][2];
#pragma unroll
    for (int mt = 0; mt < 4; ++mt)
#pragma unroll
      for (int nt = 0; nt < 2; ++nt) { const uint2 u2 = un[mt * 2 + nt]; av[mt][nt] = f32x4{bflo(u2.x), bfhi(u2.x), bflo(u2.y), bfhi(u2.y)}; }
    if (n + 1 < 32) SC_LOADU(un, n + 1);
#pragma unroll
    for (int mt = 0; mt < 4; ++mt)
#pragma unroll
      for (int ks = 0; ks < 4; ++ks) {
        const bf16x8 af = *(const bf16x8*)(B + (mt * 4 + ks) * 1024);
        av[mt][0] = MFMA16(af, Sb[ks][0], av[mt][0]);
        av[mt][1] = MFMA16(af, Sb[ks][1], av[mt][1]);
      }
    bf16x8 vbf[2][2];
#pragma unroll
    for (int k2 = 0; k2 < 2; ++k2)
#pragma unroll
      for (int nt = 0; nt < 2; ++nt) vbf[k2][nt] = pack8(av[2 * k2][nt], av[2 * k2 + 1][nt]);
    {
      unsigned char* sn = sn0 + (size_t)n * 32768 + lane * 16;
      unsigned char* vn = vn0 + (size_t)n * 16384 + lane * 16;
#pragma unroll
      for (int ks = 0; ks < 4; ++ks)
#pragma unroll
        for (int nt = 0; nt < 2; ++nt) *(bf16x8*)(sn + (ks * 8 + 2 * wave + nt) * 1024) = Sb[ks][nt];
#pragma unroll
      for (int k2 = 0; k2 < 2; ++k2)
#pragma unroll
        for (int nt = 0; nt < 2; ++nt) *(bf16x8*)(vn + (k2 * 8 + 2 * wave + nt) * 1024) = vbf[k2][nt];
    }
    const float egl = egl_s[n];
#pragma unroll
    for (int mk = 0; mk < 8; ++mk) {
#pragma unroll
      for (int nt = 0; nt < 2; ++nt) { S[mk][nt][0] *= egl; S[mk][nt][1] *= egl; S[mk][nt][2] *= egl; S[mk][nt][3] *= egl; }
#pragma unroll
      for (int k2 = 0; k2 < 2; ++k2) {
        const bf16x8 af = *(const bf16x8*)(B + 16384 + (mk * 2 + k2) * 1024);
        S[mk][0] = MFMA16(af, vbf[k2][0], S[mk][0]);
        S[mk][1] = MFMA16(af, vbf[k2][1], S[mk][1]);
      }
    }
#pragma unroll
    for (int ks = 0; ks < 4; ++ks)
#pragma unroll
      for (int nt = 0; nt < 2; ++nt) Sb[ks][nt] = pack8(S[2 * ks][nt], S[2 * ks + 1][nt]);
    if (n + 1 < 32) SC_STOREL((n + 1) & 1);
    if (n + 2 < 32) SC_LOADC(n + 2);
    __syncthreads();
  }
  asm volatile("s_waitcnt vmcnt(0)" ::: "memory");
  asm volatile("" :: "v"(warm));
  __syncthreads();
  if (tid == 0) {
    __builtin_amdgcn_fence(__ATOMIC_RELEASE, "agent");
    asm volatile("s_waitcnt vmcnt(0)" ::: "memory");
    __hip_atomic_store((unsigned*)(p.ws + OFF_CTR) + 128 + bh, 1u, __ATOMIC_RELAXED, __HIP_MEMORY_SCOPE_AGENT);
  }
}

DI void p4_dnout(const Params& p, int ci, char* smem, int wv) {
  int tid_ = (wv << 6) | lane_id(); asm volatile("" : "+v"(tid_)); const int tid = tid_, wave = tid >> 6, lane = tid & 63, fr = lane & 15, fq = lane >> 4;
  const int n = ci & 31, h = (ci >> 5) & 3, b = ci >> 7;
  float* rd = (float*)smem;
  const unsigned char* base = p.ws + OFF_DN + (size_t)ci * DN_CHUNK_B;
  const uint4* qg = (const uint4*)(base + DN_QG) + lane;
  const uint4* aa = (const uint4*)(base + DN_A) + lane;
  const unsigned char* sn = (const unsigned char*)p.out + OUT_SN + (size_t)ci * 32768 + lane * 16;
  const unsigned char* vn = (const unsigned char*)p.out + OUT_VN + (size_t)ci * 16384 + lane * 16;
  bf16x8 Sb[4][2], vbf[2][2];
#pragma unroll
  for (int ks = 0; ks < 4; ++ks)
#pragma unroll
    for (int nt = 0; nt < 2; ++nt) Sb[ks][nt] = *(const bf16x8*)(sn + (ks * 8 + 2 * wave + nt) * 1024);
#pragma unroll
  for (int k2 = 0; k2 < 2; ++k2)
#pragma unroll
    for (int nt = 0; nt < 2; ++nt) vbf[k2][nt] = *(const bf16x8*)(vn + (k2 * 8 + 2 * wave + nt) * 1024);
  f32x4 ao[4][2];
#pragma unroll
  for (int mt = 0; mt < 4; ++mt) {
    ao[mt][0] = f32x4{0.f, 0.f, 0.f, 0.f}; ao[mt][1] = f32x4{0.f, 0.f, 0.f, 0.f};
#pragma unroll
    for (int ks = 0; ks < 4; ++ks) {
      const bf16x8 af = __builtin_bit_cast(bf16x8, qg[(mt * 4 + ks) * 64]);
      ao[mt][0] = MFMA16(af, Sb[ks][0], ao[mt][0]);
      ao[mt][1] = MFMA16(af, Sb[ks][1], ao[mt][1]);
    }
#pragma unroll
    for (int k2 = 0; k2 < 2; ++k2) {
      const bf16x8 af = __builtin_bit_cast(bf16x8, aa[(mt * 2 + k2) * 64]);
      ao[mt][0] = MFMA16(af, vbf[k2][0], ao[mt][0]);
      ao[mt][1] = MFMA16(af, vbf[k2][1], ao[mt][1]);
    }
  }
  float gn[2];
  gn[0] = p.dn_out_gain[32 * wave + fr]; gn[1] = p.dn_out_gain[32 * wave + 16 + fr];
  const u16* proj = (const u16*)(p.ws + OFF_PROJ);
  u16* mixed = (u16*)(p.ws + OFF_HB);
#pragma unroll
  for (int mt = 0; mt < 4; ++mt)
#pragma unroll
    for (int j = 0; j < 4; ++j) {
      float s = ao[mt][0][j] * ao[mt][0][j] + ao[mt][1][j] * ao[mt][1][j];
      s += lx<1>(s); s += lx<2>(s); s += lx<4>(s); s += lx<8>(s);
      if (fr == 0) rd[wave * 64 + 16 * mt + 4 * fq + j] = s;
    }
  __syncthreads();
#pragma unroll
  for (int mt = 0; mt < 4; ++mt)
#pragma unroll
    for (int j = 0; j < 4; ++j) {
      const int c = 16 * mt + 4 * fq + j;
      const float tot = rd[c] + rd[64 + c] + rd[128 + c] + rd[192 + c];
      const float rstd = rsqrtf(tot * (1.f / 128.f) + EPSV);
      const size_t tok = (size_t)b * SEQ + n * 64 + c;
#pragma unroll
      for (int nt = 0; nt < 2; ++nt) {
        const int dv = 32 * wave + 16 * nt + fr;
        const float z = bf2f(proj[tok * NP + C_DNZ + h * 128 + dv]);
        mixed[tok * 1024 + h * 128 + dv] = f2bf(ao[mt][nt][j] * rstd * gn[nt] * silu_f(z));
      }
    }
  __syncthreads();
}

DI void p3_attn(const Params& p, int bh, int qb, char* smem, int wv) {
  int tid_ = (wv << 6) | lane_id(); asm volatile("" : "+v"(tid_)); const int tid = tid_, wave = tid >> 6, lane = tid & 63, fr = lane & 15, fq = lane >> 4;
  const int b = bh >> 2, h = bh & 3;
  char* Ks = smem; char* Vs = smem + 32768;
  const u16* proj = (const u16*)(p.ws + OFF_PROJ);
  const size_t tokb = (size_t)b * SEQ;
  const int qrow = qb * 64 + 16 * wave + fr;
  bf16x8 qf[2][2];
#pragma unroll
  for (int mp = 0; mp < 2; ++mp)
#pragma unroll
    for (int ks = 0; ks < 2; ++ks) qf[mp][ks] = __builtin_bit_cast(bf16x8, __builtin_nontemporal_load((const f32x4*)(proj + (tokb + qrow) * NP + C_DFQ + h * 128 + mp * 64 + 32 * ks + 8 * fq)));
  f32x4 O[2][8];
#pragma unroll
  for (int mp = 0; mp < 2; ++mp)
#pragma unroll
    for (int i = 0; i < 8; ++i) O[mp][i] = f32x4{0.f, 0.f, 0.f, 0.f};
  float mrun[2] = {-INFINITY, -INFINITY}, lrun[2] = {0.f, 0.f};
  const int ntiles = qb + 1;
  const int srow = tid >> 4, c16 = tid & 15;
  const int koff = srow * 256 + ((c16 ^ (srow & 15)) << 4);
  const int voff = srow * 256 + (((c16 >> 1) ^ (srow & 7)) << 5) + ((c16 & 1) << 4);
  const u16* kg = proj + (tokb + srow) * NP + C_DFK + h * 128 + c16 * 8;
  const u16* vg = proj + (tokb + srow) * NP + C_DFV + h * 128 + c16 * 8;
  uint4 rk[4], rv[4];
#pragma unroll
  for (int i = 0; i < 4; ++i) { rk[i] = *(const uint4*)(kg + (size_t)(16 * i) * NP); rv[i] = *(const uint4*)(vg + (size_t)(16 * i) * NP); }
#pragma unroll
  for (int i = 0; i < 4; ++i) { *(uint4*)(Ks + koff + i * 4096) = rk[i]; *(uint4*)(Vs + voff + i * 4096) = rv[i]; }
  __syncthreads();
  const int trr = fr >> 2, trp = fr & 3;
  for (int kt = 0; kt < ntiles; ++kt) {
    const int buf = (kt & 1) * 16384;
    if (kt + 1 < ntiles) {
#pragma unroll
      for (int i = 0; i < 4; ++i) {
        rk[i] = *(const uint4*)(kg + (size_t)((kt + 1) * 64 + 16 * i) * NP);
        rv[i] = *(const uint4*)(vg + (size_t)((kt + 1) * 64 + 16 * i) * NP);
      }
    }
    f32x4 st[2][4];
#pragma unroll
    for (int mp = 0; mp < 2; ++mp)
#pragma unroll
      for (int mt = 0; mt < 4; ++mt) {
        st[mp][mt] = f32x4{0.f, 0.f, 0.f, 0.f};
#pragma unroll
        for (int ks = 0; ks < 2; ++ks) {
          const bf16x8 ka = *(const bf16x8*)(Ks + buf + (16 * mt + fr) * 256 + (((mp * 8 + ks * 4 + fq) ^ fr) << 4));
          st[mp][mt] = MFMA16(ka, qf[mp][ks], st[mp][mt]);
        }
      }
    if (kt == qb) {
#pragma unroll
      for (int mt = 0; mt < 4; ++mt)
#pragma unroll
        for (int j = 0; j < 4; ++j) {
          const int key = kt * 64 + 16 * mt + 4 * fq + j;
          if (key > qrow) { st[0][mt][j] = -INFINITY; st[1][mt][j] = -INFINITY; }
        }
    }
    bf16x8 pf[2][2];
#pragma unroll
    for (int mp = 0; mp < 2; ++mp) {
      float mx = st[mp][0][0];
#pragma unroll
      for (int mt = 0; mt < 4; ++mt)
#pragma unroll
        for (int j = 0; j < 4; ++j) mx = fmaxf(mx, st[mp][mt][j]);
      mx = fmaxf(mx, lx<16>(mx)); mx = lx32_max(mx);
      const float mnew = fmaxf(mrun[mp], mx);
      const float alpha = __builtin_amdgcn_exp2f(mrun[mp] - mnew);
      mrun[mp] = mnew;
      float ps = 0.f;
#pragma unroll
      for (int mt = 0; mt < 4; ++mt)
#pragma unroll
        for (int j = 0; j < 4; ++j) { const float e = __builtin_amdgcn_exp2f(st[mp][mt][j] - mnew); st[mp][mt][j] = e; ps += e; }
      lrun[mp] = lrun[mp] * alpha + ps;
      if (__builtin_amdgcn_ballot_w64(alpha != 1.f) != 0ull) {
#pragma unroll
        for (int i = 0; i < 8; ++i) { O[mp][i][0] *= alpha; O[mp][i][1] *= alpha; O[mp][i][2] *= alpha; O[mp][i][3] *= alpha; }
      }
      pf[mp][0] = pack8(st[mp][0], st[mp][1]);
      pf[mp][1] = pack8(st[mp][2], st[mp][3]);
    }
#pragma unroll
    for (int k2 = 0; k2 < 2; ++k2) {
      const int r0 = 32 * k2 + 4 * fq + trr, r1 = r0 + 16;
#pragma unroll
      for (int mv = 0; mv < 8; ++mv) {
        const s16x4 lo = vtr(Vs + buf + r0 * 256 + ((mv ^ (r0 & 7)) << 5) + 8 * trp);
        const s16x4 hi = vtr(Vs + buf + r1 * 256 + ((mv ^ (r1 & 7)) << 5) + 8 * trp);
        const bf16x8 va = __builtin_shufflevector(lo, hi, 0, 1, 2, 3, 4, 5, 6, 7);
        O[0][mv] = MFMA16(va, pf[0][k2], O[0][mv]);
        O[1][mv] = MFMA16(va, pf[1][k2], O[1][mv]);
      }
    }
    if (kt + 1 < ntiles) {
      const int nb = ((kt + 1) & 1) * 16384;
#pragma unroll
      for (int i = 0; i < 4; ++i) { *(uint4*)(Ks + nb + koff + i * 4096) = rk[i]; *(uint4*)(Vs + nb + voff + i * 4096) = rv[i]; }
    }
    __syncthreads();
  }
  int tid2 = (wv << 6) | lane_id(); asm volatile("" : "+v"(tid2));
  const int qrow_e = qb * 64 + 16 * (tid2 >> 6) + (tid2 & 15), fq_e = (tid2 >> 4) & 3;
  float inv[2];
#pragma unroll
  for (int mp = 0; mp < 2; ++mp) { float l = lrun[mp]; l += lx<16>(l); l = lx32_sum(l); inv[mp] = 1.f / l; }
  const float li = *(const float*)(smem + 73744) * inv[1];
  float ss = 0.f;
#pragma unroll
  for (int mv = 0; mv < 8; ++mv)
#pragma unroll
    for (int j = 0; j < 4; ++j) { const float o = O[0][mv][j] * inv[0] - li * O[1][mv][j]; O[0][mv][j] = o; ss += o * o; }
  ss += lx<16>(ss); ss = lx32_sum(ss);
  const float rstd = rsqrtf(ss * (1.f / 128.f) + EPSV) * 0.8f;
  u16* mixed = (u16*)(p.ws + OFF_HB);
#pragma unroll
  for (int mv = 0; mv < 8; ++mv) {
    const int dv = 16 * mv + 4 * fq_e;
    typedef unsigned u32x2 __attribute__((ext_vector_type(2)));
    const u32x2 zz_ = __builtin_nontemporal_load((const u32x2*)(proj + (tokb + qrow_e) * NP + C_DFZ + h * 128 + dv));
    const uint2 zz = make_uint2(zz_[0], zz_[1]);
    const float4 g4 = *(const float4*)(p.df_out_gain + dv);
    uint2 o;
    o.x = cvtpk(O[0][mv][0] * rstd * g4.x * silu_f(bflo(zz.x)), O[0][mv][1] * rstd * g4.y * silu_f(bfhi(zz.x)));
    o.y = cvtpk(O[0][mv][2] * rstd * g4.z * silu_f(bflo(zz.y)), O[0][mv][3] * rstd * g4.w * silu_f(bfhi(zz.y)));
    *(uint2*)(mixed + (tokb + qrow_e) * 1024 + 512 + h * 128 + dv) = o;
  }
}

#define XB_TMO      128
#define XB_XCNT(j)  (256  + 64 * (j))
#define XB_XSUB(j)  (1280 + 64 * (j))
#define XB_XGEN(j)  (2304 + 64 * (j))
#define XB_TOP      3328
#define XB_TOPGEN   3392
#define XCD_BAR_WORDS 3456
#define XB_SPIN_CAP (1u << 18)
#define LAS __attribute__((address_space(3)))
DI unsigned xb_ld(unsigned* p) { return __hip_atomic_load(p, __ATOMIC_RELAXED, __HIP_MEMORY_SCOPE_AGENT); }
DI unsigned xb_add(unsigned* p, unsigned v) { return __hip_atomic_fetch_add(p, v, __ATOMIC_RELAXED, __HIP_MEMORY_SCOPE_AGENT); }
DI unsigned xb_xcc_id() { return (unsigned)__builtin_amdgcn_s_getreg((3 << 11) | 20) & 0xFu; }
#define XB_SPIN(cond, bar) do { unsigned _sp = 0; while (cond) { __builtin_amdgcn_s_sleep(8);   \
    if ((++_sp & 255u) == 0u) { if (xb_ld(&(bar)[XB_TMO])) break; if (_sp > XB_SPIN_CAP) { atomicAdd(&(bar)[XB_TMO], 1u); break; } } } } while (0)
DI void xcd_barrier_complete(unsigned* bar, unsigned x, unsigned& nloc, unsigned& nx) {
  const unsigned G = gridDim.x;
  unsigned sum, cnt, mine, sp = 0u;
  for (;;) {
    sum = 0u; cnt = 0u; mine = 0u;
#pragma unroll
    for (unsigned j = 0; j < 16; ++j) { const unsigned c = xb_ld(&bar[XB_XCNT(j)]); sum += c; cnt += (c > 0u) ? 1u : 0u; mine = (j == x) ? c : mine; }
    if (sum == G) break;
    __builtin_amdgcn_s_sleep(1);
    if ((++sp & 255u) == 0u) { if (xb_ld(&bar[XB_TMO])) break; if (sp > XB_SPIN_CAP) { atomicAdd(&bar[XB_TMO], 1u); break; } }
  }
  nloc = mine > 0u ? mine : 1u; nx = cnt > 0u ? cnt : 1u;
}
DI void xcd_barrier(unsigned* bar, volatile LAS unsigned* st, bool leader) {
  asm volatile("s_waitcnt vmcnt(0)" ::: "memory");
  __syncthreads();
  if (leader) {
    const unsigned x = xb_xcc_id();
    __builtin_amdgcn_s_waitcnt(0);
    unsigned nloc = st[0], nx = st[1];
    if (nloc == 0u) { xcd_barrier_complete(bar, x, nloc, nx); st[0] = nloc; st[1] = nx; }
    const unsigned old = xb_add(&bar[XB_XSUB(x)], 1u);
    const unsigned gen = old / nloc;
    if (old + 1u == (gen + 1u) * nloc) {
      __builtin_amdgcn_fence(__ATOMIC_RELEASE, "agent");
      asm volatile("s_waitcnt vmcnt(0)" ::: "memory");
      const unsigned og = xb_add(&bar[XB_TOP], 1u);
      const unsigned tg = og / nx;
      if (og + 1u == (tg + 1u) * nx) xb_add(&bar[XB_TOPGEN], 1u);
      else XB_SPIN(xb_ld(&bar[XB_TOPGEN]) == tg, bar);
      __builtin_amdgcn_fence(__ATOMIC_ACQUIRE, "agent");
      xb_add(&bar[XB_XGEN(x)], 1u);
      asm volatile("s_waitcnt vmcnt(0)" ::: "memory");
    } else {
      XB_SPIN(xb_ld(&bar[XB_XGEN(x)]) == gen, bar);
      __builtin_amdgcn_fence(__ATOMIC_ACQUIRE, "agent");
      asm volatile("s_waitcnt vmcnt(0)" ::: "memory");
    }
  }
  __syncthreads();
}

template <int ONLY>
__global__ void __launch_bounds__(256, 2) fwd_kernel(Params p) {
  __shared__ __attribute__((aligned(16))) char smem[SMEM_BYTES];
  const int nb = gridDim.x, bid = blockIdx.x;
  const int wv = __builtin_amdgcn_readfirstlane((int)(threadIdx.x >> 6));
  __shared__ uint4 xb_words;
  unsigned* const gbar = (unsigned*)(p.ws + OFF_BAR);
  volatile LAS unsigned* const xst = (volatile LAS unsigned*)&xb_words;
  if (ONLY < 0) {
    if (wv == 0 && lane_id() == 0) { xb_words = make_uint4(0u, 0u, 0u, 0u); (void)xb_add(&gbar[XB_XCNT(xb_xcc_id())], 1u); }
    __syncthreads();
    if (p.coop == 2) cg::this_grid().sync();
  }
#define GRID_SYNC() xcd_barrier(gbar, xst, wv == 0 && lane_id() == 0)
  if (ONLY < 0 || ONLY == 0) {
    if (bid == 0 && wv < 3) ((unsigned*)(p.ws + OFF_CTR))[(wv << 6) | lane_id()] = 0u;
    for (int it = bid; it < 1024 + 256; it += nb) {
      if (it < 1024) p0_transpose(p.w_in, WIN_LD, true, (u16*)(p.ws + OFF_WTIN), it & 15, it >> 4, smem, wv);
      else { const int t = it - 1024; p0_transpose(p.w_out, 1024, false, (u16*)(p.ws + OFF_WTOUT), t & 15, t >> 4, smem, wv); }
    }
    p0_fill_w8(p, smem, wv);
    __syncthreads();
    for (int it = bid; it < 4096; it += nb) p0_rows(p, it, smem, wv);
    __syncthreads();
  }
  if (ONLY < 0) GRID_SYNC();
  if (ONLY < 0 || ONLY == 1) {
    for (int rep = 0; rep < REP_G1; ++rep)
    for (int it = bid; it < 4096; it += nb)
      gemm_tile<1>(p, (const u16*)(p.ws + OFF_HB), (const u16*)(p.ws + OFF_WTIN), (it >> 5) * 128, (it & 31) * 128, smem, wv);
  }
  if (ONLY < 0) GRID_SYNC();
  if (ONLY < 0 || ONLY == 2) {
    for (int l = bid >> 3; l < 128; l += (nb >> 3)) p2_prep(p, (bid & 7) * 128 + l, smem, wv);
#if REP_PREP > 1
    for (int it = bid; it < 1024; it += nb) p2_prep(p, it, smem, wv);
#endif
  }
  if (ONLY < 0) GRID_SYNC();
  if (ONLY < 0 || ONLY == 3) {
    const int lane = lane_id();
    const float s1 = wave_sum(p.lq1[lane] * p.lk1[lane]), s2 = wave_sum(p.lq2[lane] * p.lk2[lane]);
    if (wv == 0 && lane == 0) *(float*)(smem + 73744) = __expf(s1) - __expf(s2) + 0.2f;
    __syncthreads();
    if (bid < 32) p3_scan(p, (bid & 7) * 4 + (bid >> 3), smem, wv);
    int* slot = (int*)(smem + 73728);
    const int xcc = bid & 7;
    for (int qi = 0; qi < 8; ++qi) {
      const int qx = (xcc + qi) & 7;
      unsigned* ctr = (unsigned*)(p.ws + OFF_CTR) + qx * 16;
      while (true) {
        if (wv == 0 && lane == 0) *slot = (int)atomicAdd(ctr, 1u);
        __syncthreads();
        const int it = *slot;
        __syncthreads();
        if (it >= 256) break;
        if (it < 128) {
          p3_attn(p, qx * 4 + (it & 3), 31 - (it >> 2), smem, wv);
        } else {
          const int bh = qx * 4 + (it & 3);
          if (wv == 0 && lane == 0) {
            unsigned* fl = (unsigned*)(p.ws + OFF_CTR) + 128 + bh;
            while (__hip_atomic_load(fl, __ATOMIC_RELAXED, __HIP_MEMORY_SCOPE_AGENT) == 0u) __builtin_amdgcn_s_sleep(2);
            __builtin_amdgcn_fence(__ATOMIC_ACQUIRE, "agent");
            asm volatile("s_waitcnt vmcnt(0)" ::: "memory");
          }
          __syncthreads();
          p4_dnout(p, bh * 32 + ((it - 128) >> 2), smem, wv);
        }
      }
    }
  }
  if (ONLY < 0) GRID_SYNC();
  if (ONLY < 0 || ONLY == 5) {
    for (int it = bid; it < 1024; it += nb) {
      const int xq = it & 7, s = it >> 3;
      gemm_tile<2>(p, (const u16*)(p.ws + OFF_HB), (const u16*)(p.ws + OFF_WTOUT), (xq * 16 + (s >> 3)) * 128, (s & 7) * 128, smem, wv);
    }
  }
}

extern "C" void kernel_launch(void* const* d_in, const int* in_sizes, int n_in, void* d_out, int out_size, void* d_ws, size_t ws_size,
                              hipStream_t stream) {
  Params p{};
  p.x = (const float*)d_in[0]; p.norm_gain = (const float*)d_in[1]; p.w_in = (const float*)d_in[2]; p.conv_w = (const float*)d_in[3];
  p.a_log = (const float*)d_in[4]; p.dt_bias = (const float*)d_in[5]; p.dn_out_gain = (const float*)d_in[6]; p.q_gain = (const float*)d_in[7];
  p.k_gain = (const float*)d_in[8]; p.lq1 = (const float*)d_in[9]; p.lk1 = (const float*)d_in[10]; p.lq2 = (const float*)d_in[11];
  p.lk2 = (const float*)d_in[12]; p.df_out_gain = (const float*)d_in[13]; p.w_out = (const float*)d_in[14];
  p.out = (float*)d_out; p.ws = (unsigned char*)d_ws;
  static int grid_blocks = 0;
  if (!grid_blocks) {
    int dev = 0, cus = 0, per_cu = 0;
    (void)hipGetDevice(&dev);
    (void)hipDeviceGetAttribute(&cus, hipDeviceAttributeMultiprocessorCount, dev);
#if USE_COOP
    (void)hipOccupancyMaxActiveBlocksPerMultiprocessor(&per_cu, fwd_kernel<-1>, 256, 0);
#else
    per_cu = 2;
#endif
    if (per_cu > 2) per_cu = 2;
    if (per_cu < 1) per_cu = 1;
    grid_blocks = cus * per_cu;
  }
#if USE_COOP
  (void)hipMemsetAsync((unsigned char*)d_ws + OFF_BAR, 0, 3456 * 4, stream);
  p.phase_lo = 0; p.phase_hi = 5; p.coop = 1;
  void* args[] = {&p};
  hipError_t e = hipLaunchCooperativeKernel((void*)fwd_kernel<-1>, dim3(grid_blocks), dim3(256), args, 0, stream);
  if (e != hipSuccess) fprintf(stderr, "cooperative launch failed: %s (grid %d)\n", hipGetErrorString(e), grid_blocks);
#else
  p.coop = 0;
  p.phase_lo = 0; p.phase_hi = 1; hipLaunchKernelGGL(fwd_kernel<0>, dim3(grid_blocks), dim3(256), 0, stream, p);
  p.phase_lo = 1; p.phase_hi = 2; hipLaunchKernelGGL(fwd_kernel<1>, dim3(grid_blocks), dim3(256), 0, stream, p);
  p.phase_lo = 2; p.phase_hi = 3; hipLaunchKernelGGL(fwd_kernel<2>, dim3(grid_blocks), dim3(256), 0, stream, p);
  p.phase_lo = 3; p.phase_hi = 4; hipLaunchKernelGGL(fwd_kernel<3>, dim3(grid_blocks), dim3(256), 0, stream, p);
  p.phase_lo = 4; p.phase_hi = 5; hipLaunchKernelGGL(fwd_kernel<4>, dim3(grid_blocks), dim3(256), 0, stream, p);
  p.phase_lo = 5; p.phase_hi = 6; hipLaunchKernelGGL(fwd_kernel<5>, dim3(grid_blocks), dim3(256), 0, stream, p);
#endif
}
```

```cpp
#include <hip/hip_runtime.h>
#include <hip/hip_cooperative_groups.h>
#include <cstdio>
#include <cstdint>
namespace cg = cooperative_groups;

#ifndef REP_P0
#define REP_P0 1
#endif
#ifndef REP_DNOUT
#define REP_DNOUT 1
#endif
#ifndef REP_G1
#define REP_G1 1
#endif
#ifndef REP_PREP
#define REP_PREP 1
#endif
#ifndef REP_SCAN
#define REP_SCAN 1
#endif
#ifndef REP_ATTN
#define REP_ATTN 1
#endif
#ifndef USE_COOP
#define USE_COOP 1
#endif

#define DI __device__ __forceinline__
typedef __attribute__((ext_vector_type(8))) short bf16x8;
typedef __attribute__((ext_vector_type(4))) short s16x4;
typedef __attribute__((ext_vector_type(4))) float f32x4;
typedef short v4i16_t __attribute__((ext_vector_type(4)));
typedef __attribute__((address_space(3))) const char* lds_cptr;
typedef unsigned short u16;

constexpr int SEQ = 2048, NTOK = 16384, DMODEL = 1024, NP = 4096, WIN_LD = 4104;
constexpr int C_DNQ = 0, C_DNK = 512, C_DNV = 1024, C_DNZ = 1536, C_DFQ = 2048, C_DFK = 2560, C_DFV = 3072, C_DFZ = 3584;
constexpr float EPSV = 1e-6f;
constexpr float LOG2E = 1.4426950408889634f;

constexpr size_t OFF_PROJ = 0;
constexpr size_t OFF_HB = 134217728;
constexpr size_t OFF_WTIN = OFF_HB + 33554432;
constexpr size_t OFF_WTOUT = OFF_WTIN + 8388608;
constexpr size_t OFF_G = OFF_WTOUT + 2097152;
constexpr size_t OFF_BETA = OFF_G + 262144;
constexpr size_t OFF_DN = OFF_BETA + 262144;
constexpr size_t DN_CHUNK_B = 73728;
constexpr size_t DN_NEGW = 0, DN_QG = 16384, DN_KD = 32768, DN_A = 49152, DN_U = 57344;
constexpr size_t OFF_GLAST = OFF_DN + DN_CHUNK_B * 1024;
constexpr size_t OFF_CTR = OFF_GLAST + 4096;
constexpr size_t OFF_BAR = OFF_CTR + 1024;

constexpr int SMEM_BYTES = 77824;

struct Params {
  const float *x, *norm_gain, *w_in, *conv_w, *a_log, *dt_bias, *dn_out_gain, *q_gain, *k_gain;
  const float *lq1, *lk1, *lq2, *lk2, *df_out_gain, *w_out;
  float* out;
  unsigned char* ws;
  int phase_lo, phase_hi, coop, pad0;
};

typedef __bf16 bf16x2_t __attribute__((ext_vector_type(2)));
DI unsigned cvtpk(float lo, float hi) { bf16x2_t v; v[0] = (__bf16)lo; v[1] = (__bf16)hi; return __builtin_bit_cast(unsigned, v); }
DI float bf2f(u16 h) { return __uint_as_float(((unsigned)h) << 16); }
DI float bflo(unsigned u) { return __uint_as_float(u << 16); }
DI float bfhi(unsigned u) { return __uint_as_float(u & 0xffff0000u); }
DI u16 f2bf(float x) { return (u16)(cvtpk(x, 0.f) & 0xffffu); }
template <int X> DI float lx(float v) { return __builtin_bit_cast(float, __builtin_amdgcn_ds_swizzle(__builtin_bit_cast(int, v), 0x1f | (X << 10))); }
DI float lx32_sum(float v) { auto rr = __builtin_amdgcn_permlane32_swap(__float_as_uint(v), __float_as_uint(v), false, false); return __uint_as_float(rr[0]) + __uint_as_float(rr[1]); }
DI float lx32_max(float v) { auto rr = __builtin_amdgcn_permlane32_swap(__float_as_uint(v), __float_as_uint(v), false, false); return fmaxf(__uint_as_float(rr[0]), __uint_as_float(rr[1])); }
DI float wave_sum(float v) {
  v += lx<1>(v); v += lx<2>(v); v += lx<4>(v); v += lx<8>(v); v += lx<16>(v);
  return lx32_sum(v);
}
DI int lane_id() { int l; asm volatile("v_mbcnt_lo_u32_b32 %0, -1, 0\n\tv_mbcnt_hi_u32_b32 %0, -1, %0" : "=v"(l)); return l; }
DI float silu_f(float y) { return y * __builtin_amdgcn_rcpf(1.f + __expf(-y)); }
DI s16x4 vtr(const char* p) { return __builtin_bit_cast(s16x4, __builtin_amdgcn_ds_read_tr16_b64_v4i16((__attribute__((address_space(3))) v4i16_t*)(lds_cptr)p)); }
#define MFMA16(a, b, c) __builtin_amdgcn_mfma_f32_16x16x32_bf16((a), (b), (c), 0, 0, 0)
DI bf16x8 pack8(const f32x4& a, const f32x4& b) {
  uint4 u; u.x = cvtpk(a[0], a[1]); u.y = cvtpk(a[2], a[3]); u.z = cvtpk(b[0], b[1]); u.w = cvtpk(b[2], b[3]);
  return __builtin_bit_cast(bf16x8, u);
}

DI void p0_fill_w8(const Params& p, char* smem, int wv) {
  int tid_ = (wv << 6) | lane_id(); asm volatile("" : "+v"(tid_)); const int tid = tid_;
  float4* pl = (float4*)smem;
#pragma unroll
  for (int j = 0; j < 8; ++j) {
    const int q = tid + 256 * j, k = q >> 1, c4 = q & 1;
    pl[(c4 * 4 + (k & 3)) * 256 + (k >> 2)] = *(const float4*)(p.w_in + (size_t)k * WIN_LD + 2048 + 4 * c4);
  }
}
DI void p0_rows(const Params& p, int item, char* smem, int wv) {
  int tid_ = (wv << 6) | lane_id(); asm volatile("" : "+v"(tid_)); const int tid = tid_, wave = tid >> 6, lane = tid & 63;
  const int row = item * 4 + wave;
  const float4* pl = (const float4*)smem;
  const float4* xr = (const float4*)(p.x + (size_t)row * 1024);
  float4 xv[4]; float ss = 0.f;
  float acc[8];
#pragma unroll
  for (int j = 0; j < 8; ++j) acc[j] = 0.f;
#pragma unroll
  for (int i = 0; i < 4; ++i) {
    { const f32x4 t4 = __builtin_nontemporal_load((const f32x4*)xr + lane + 64 * i); xv[i] = make_float4(t4[0], t4[1], t4[2], t4[3]); }
    const float4 g = ((const float4*)p.norm_gain)[lane + 64 * i];
    ss += xv[i].x * xv[i].x + xv[i].y * xv[i].y + xv[i].z * xv[i].z + xv[i].w * xv[i].w;
    xv[i].x *= g.x; xv[i].y *= g.y; xv[i].z *= g.z; xv[i].w *= g.w;
    const float hh[4] = {xv[i].x, xv[i].y, xv[i].z, xv[i].w};
#pragma unroll
    for (int e = 0; e < 4; ++e) {
      const float4 w0 = pl[(0 + e) * 256 + lane + 64 * i], w1 = pl[(4 + e) * 256 + lane + 64 * i];
      acc[0] += hh[e] * w0.x; acc[1] += hh[e] * w0.y; acc[2] += hh[e] * w0.z; acc[3] += hh[e] * w0.w;
      acc[4] += hh[e] * w1.x; acc[5] += hh[e] * w1.y; acc[6] += hh[e] * w1.z; acc[7] += hh[e] * w1.w;
    }
  }
  ss = wave_sum(ss);
#pragma unroll
  for (int j = 0; j < 8; ++j) acc[j] = wave_sum(acc[j]);
  const float rstd = rsqrtf(ss * (1.f / 1024.f) + EPSV);
  u16* hb = (u16*)(p.ws + OFF_HB);
#pragma unroll
  for (int i = 0; i < 4; ++i) {
    uint2 pk; pk.x = cvtpk(xv[i].x * rstd, xv[i].y * rstd); pk.y = cvtpk(xv[i].z * rstd, xv[i].w * rstd);
    *(uint2*)(hb + (size_t)row * 1024 + (lane + 64 * i) * 4) = pk;
  }
  if (lane < 8) {
    float v = acc[0];
    v = lane == 1 ? acc[1] : v; v = lane == 2 ? acc[2] : v; v = lane == 3 ? acc[3] : v;
    v = lane == 4 ? acc[4] : v; v = lane == 5 ? acc[5] : v; v = lane == 6 ? acc[6] : v; v = lane == 7 ? acc[7] : v;
    v *= rstd;
    const int hd = lane & 3;
    if (lane < 4) {
      ((float*)(p.ws + OFF_BETA))[row * 4 + hd] = 1.f / (1.f + expf(-v));
    } else {
      const float a = v + p.dt_bias[hd];
      const float sp = fmaxf(a, 0.f) + log1pf(expf(-fabsf(a)));
      ((float*)(p.ws + OFF_G))[row * 4 + hd] = -expf(p.a_log[hd]) * sp;
    }
  }
}

DI void p0_transpose(const float* __restrict__ W, int ldw, bool is_win, u16* __restrict__ Wt, int kt, int nt, char* smem, int wv) {
  float* tile = (float*)smem;
  int tid_ = (wv << 6) | lane_id(); asm volatile("" : "+v"(tid_)); const int tid = tid_;
  const int c = tid & 63;
  const int n = nt * 64 + c;
  const int col = n + ((is_win && n >= 2048) ? 8 : 0);
#pragma unroll
  for (int i = 0; i < 16; ++i) {
    const int r = (tid >> 6) + 4 * i;
    tile[r * 65 + c] = __builtin_nontemporal_load(W + (size_t)(kt * 64 + r) * ldw + col);
  }
  __syncthreads();
  const int nn = tid >> 2, kp = (tid & 3) * 16;
  unsigned pk[8];
#pragma unroll
  for (int e = 0; e < 8; ++e) pk[e] = cvtpk(tile[(kp + 2 * e) * 65 + nn], tile[(kp + 2 * e + 1) * 65 + nn]);
  uint4* dst = (uint4*)(Wt + (size_t)(nt * 64 + nn) * 1024 + kt * 64 + kp);
  dst[0] = make_uint4(pk[0], pk[1], pk[2], pk[3]);
  dst[1] = make_uint4(pk[4], pk[5], pk[6], pk[7]);
  __syncthreads();
}

template <int EPI>
DI void gemm_tile(const Params& p, const u16* __restrict__ A, const u16* __restrict__ Bt, int m0, int n0, char* smem, int wv) {
  constexpr int K = 1024, NKT = K / 64;
  int tid_ = (wv << 6) | lane_id(); asm volatile("" : "+v"(tid_)); const int tid = tid_, wave = tid >> 6, lane = tid & 63, fr = lane & 15, fq = lane >> 4, wr = wave >> 1, wc = wave & 1;
  f32x4 acc[4][4];
#pragma unroll
  for (int i = 0; i < 4; ++i)
#pragma unroll
    for (int j = 0; j < 4; ++j) acc[i][j] = f32x4{0.f, 0.f, 0.f, 0.f};
  float4 xin[4][4];
  char* As = smem; char* Bs = smem + 32768;
  const int srow = tid >> 3, sc8 = (tid & 7) ^ ((tid >> 4) & 7);
  const u16* ag = A + (size_t)(m0 + srow) * K + sc8 * 8;
  const u16* bg = Bt + (size_t)(n0 + srow) * K + sc8 * 8;
#define G_GLDS(nb_, kt_) { _Pragma("unroll") for (int i = 0; i < 4; ++i) { \
    __builtin_amdgcn_global_load_lds((const unsigned*)(ag + (size_t)(32 * i) * K + (kt_) * 64), (unsigned*)(As + (nb_) + wv * 1024 + i * 4096), 16, 0, 0); \
    __builtin_amdgcn_global_load_lds((const unsigned*)(bg + (size_t)(32 * i) * K + (kt_) * 64), (unsigned*)(Bs + (nb_) + wv * 1024 + i * 4096), 16, 0, 0); } }
  G_GLDS(0, 0);
  __syncthreads();
  if (EPI == 2) {
#pragma unroll
    for (int mt = 0; mt < 4; ++mt)
#pragma unroll
      for (int nt = 0; nt < 4; ++nt)
        { const f32x4 t4 = __builtin_nontemporal_load((const f32x4*)(p.x + (size_t)(m0 + wr * 64 + mt * 16 + fr) * 1024 + n0 + wc * 64 + nt * 16 + 4 * fq));
          xin[mt][nt] = make_float4(t4[0], t4[1], t4[2], t4[3]); }
  }
  const int fsw = fr >> 1;
  for (int kt = 0; kt < NKT; ++kt) {
    const int buf = (kt & 1) * 16384;
    if (kt + 1 < NKT) G_GLDS(((kt + 1) & 1) * 16384, kt + 1);
#pragma unroll
    for (int ks = 0; ks < 2; ++ks) {
      bf16x8 af[4], bfr[4];
      const int sw = ((ks * 4 + fq) ^ fsw) << 4;
#pragma unroll
      for (int mt = 0; mt < 4; ++mt) af[mt] = *(const bf16x8*)(As + buf + (wr * 64 + mt * 16 + fr) * 128 + sw);
#pragma unroll
      for (int nt = 0; nt < 4; ++nt) bfr[nt] = *(const bf16x8*)(Bs + buf + (wc * 64 + nt * 16 + fr) * 128 + sw);
#pragma unroll
      for (int mt = 0; mt < 4; ++mt)
#pragma unroll
        for (int nt = 0; nt < 4; ++nt) acc[mt][nt] = MFMA16(bfr[nt], af[mt], acc[mt][nt]);
    }
    __syncthreads();
  }
  float qsc[4]; float4 qg4[4];
#pragma unroll
  for (int i = 0; i < 4; ++i) { qsc[i] = 1.f; qg4[i] = make_float4(1.f, 1.f, 1.f, 1.f); }
  if (EPI == 1 && n0 >= C_DFQ && n0 < C_DFV) {
    const bool isq = n0 < C_DFK;
    const float* gp = isq ? p.q_gain : p.k_gain;
#pragma unroll
    for (int nt = 0; nt < 4; ++nt) qg4[nt] = *(const float4*)(gp + nt * 16 + 4 * fq);
#pragma unroll
    for (int mt = 0; mt < 4; ++mt) {
      float ss = 0.f;
#pragma unroll
      for (int nt = 0; nt < 4; ++nt) ss += acc[mt][nt][0] * acc[mt][nt][0] + acc[mt][nt][1] * acc[mt][nt][1] + acc[mt][nt][2] * acc[mt][nt][2] + acc[mt][nt][3] * acc[mt][nt][3];
      ss += lx<16>(ss); ss = lx32_sum(ss);
      qsc[mt] = rsqrtf(ss * (1.f / 64.f) + EPSV) * (isq ? 0.125f * LOG2E : 1.f);
    }
  }
#pragma unroll
  for (int mt = 0; mt < 4; ++mt) {
    const int m = m0 + wr * 64 + mt * 16 + fr;
#pragma unroll
    for (int nt = 0; nt < 4; ++nt) {
      const int n = n0 + wc * 64 + nt * 16 + 4 * fq;
      if (EPI == 1) {
        u16* proj = (u16*)(p.ws + OFF_PROJ);
        uint2 pk; pk.x = cvtpk(acc[mt][nt][0] * qsc[mt] * qg4[nt].x, acc[mt][nt][1] * qsc[mt] * qg4[nt].y);
        pk.y = cvtpk(acc[mt][nt][2] * qsc[mt] * qg4[nt].z, acc[mt][nt][3] * qsc[mt] * qg4[nt].w);
        *(uint2*)(proj + (size_t)m * NP + n) = pk;
      } else {
        const float4 xi = xin[mt][nt];
        float4 o; o.x = xi.x + acc[mt][nt][0]; o.y = xi.y + acc[mt][nt][1]; o.z = xi.z + acc[mt][nt][2]; o.w = xi.w + acc[mt][nt][3];
        *(float4*)(p.out + (size_t)m * 1024 + n) = o;
      }
    }
  }
}

DI void p2_qknorm(const Params& p, int item, int wv) {
  int tid_ = (wv << 6) | lane_id(); asm volatile("" : "+v"(tid_)); const int tid = tid_, wave = tid >> 6, lane = tid & 63;
  const int row = item * 4 + wave;
  u16* pr = (u16*)(p.ws + OFF_PROJ) + (size_t)row * NP + C_DFQ + lane * 16;
  uint4 v0 = ((const uint4*)pr)[0], v1 = ((const uint4*)pr)[1];
  unsigned w[8] = {v0.x, v0.y, v0.z, v0.w, v1.x, v1.y, v1.z, v1.w};
  float f[16]; float ss = 0.f;
#pragma unroll
  for (int e = 0; e < 8; ++e) { f[2 * e] = bflo(w[e]); f[2 * e + 1] = bfhi(w[e]); ss += f[2 * e] * f[2 * e] + f[2 * e + 1] * f[2 * e + 1]; }
  ss += lx<1>(ss); ss += lx<2>(ss);
  const float rstd = rsqrtf(ss * (1.f / 64.f) + EPSV);
  const bool isq = lane < 32;
  const float* gp = (isq ? p.q_gain : p.k_gain) + (lane & 3) * 16;
  const float sc = rstd * (isq ? 0.125f * LOG2E : 1.f);
  unsigned o[8];
#pragma unroll
  for (int e = 0; e < 8; ++e) o[e] = cvtpk(f[2 * e] * sc * gp[2 * e], f[2 * e + 1] * sc * gp[2 * e + 1]);
  ((uint4*)pr)[0] = make_uint4(o[0], o[1], o[2], o[3]);
  ((uint4*)pr)[1] = make_uint4(o[4], o[5], o[6], o[7]);
}

DI void p2_prep(const Params& p, int item, char* smem, int wv) {
  int tid_ = (wv << 6) | lane_id(); asm volatile("" : "+v"(tid_)); const int tid = tid_, wave = tid >> 6, lane = tid & 63, fr = lane & 15, fq = lane >> 4;
  const int n = item & 31, h = (item >> 5) & 3, b = item >> 7;
  u16* qn = (u16*)smem;
  u16* kn = (u16*)(smem + 17408);
  u16* vb = (u16*)(smem + 34816);
  u16* Mb = (u16*)(smem + 51200);
  float* Md = (float*)(smem + 59392);
  u16* Dv = (u16*)(smem + 63488);
  u16* Asm = (u16*)(smem + 67584);
  float* gcs = (float*)(smem + 75776);
  float* bts = gcs + 64;
  float* egs = bts + 64;
  float* kds = egs + 64;
  const size_t tok0 = (size_t)b * SEQ + n * 64;
  const u16* proj = (const u16*)(p.ws + OFF_PROJ);
  unsigned char* dnb = p.ws + OFF_DN + (size_t)item * DN_CHUNK_B;

  if (wave == 0) {
    egs[lane] = ((const float*)(p.ws + OFF_G))[(tok0 + lane) * 4 + h];
    float gv = 0.f;
    for (int i = 0; i < 64; ++i) { const float t = egs[i]; gv += (i <= lane) ? t : 0.f; }
    gcs[lane] = gv;
    bts[lane] = ((const float*)(p.ws + OFF_BETA))[(tok0 + lane) * 4 + h];
    egs[lane] = __expf(gv);
    kds[lane] = __expf(__uint_as_float(__builtin_amdgcn_readlane(__float_as_uint(gv), 63)) - gv);
    if (lane == 63) ((float*)(p.ws + OFF_GLAST))[item] = gv;
  }
  {
    const int t0 = wave * 16;
    const u16* pcol = proj + h * 128 + 2 * lane;
    unsigned uq[19], uk[19], uv[19];
#pragma unroll
    for (int j = 0; j < 19; ++j) {
      const int tt = n * 64 + t0 - 3 + j;
      uq[j] = 0u; uk[j] = 0u; uv[j] = 0u;
      if (tt >= 0) {
        const u16* pp = pcol + ((size_t)b * SEQ + tt) * NP;
        uq[j] = __builtin_nontemporal_load((const unsigned*)(pp + C_DNQ)); uk[j] = __builtin_nontemporal_load((const unsigned*)(pp + C_DNK)); uv[j] = __builtin_nontemporal_load((const unsigned*)(pp + C_DNV));
      }
    }
    float2 cwq[4], cwk[4], cwv[4];
#pragma unroll
    for (int j = 0; j < 4; ++j) {
      cwq[j] = *(const float2*)(p.conv_w + j * 1536 + h * 128 + 2 * lane);
      cwk[j] = *(const float2*)(p.conv_w + j * 1536 + 512 + h * 128 + 2 * lane);
      cwv[j] = *(const float2*)(p.conv_w + j * 1536 + 1024 + h * 128 + 2 * lane);
    }
    asm volatile("" ::: "memory");
    float yqx[16], yqy[16], ykx[16], yky[16], sq[16], sk[16];
#pragma unroll
    for (int tt = 0; tt < 16; ++tt) {
      float ax = 0.f, ay = 0.f, bx = 0.f, by = 0.f, cx = 0.f, cy = 0.f;
#pragma unroll
      for (int j = 0; j < 4; ++j) {
        ax += cwq[j].x * bflo(uq[tt + j]); ay += cwq[j].y * bfhi(uq[tt + j]);
        bx += cwk[j].x * bflo(uk[tt + j]); by += cwk[j].y * bfhi(uk[tt + j]);
        cx += cwv[j].x * bflo(uv[tt + j]); cy += cwv[j].y * bfhi(uv[tt + j]);
      }
      ax = silu_f(ax); ay = silu_f(ay); bx = silu_f(bx); by = silu_f(by); cx = silu_f(cx); cy = silu_f(cy);
      yqx[tt] = ax; yqy[tt] = ay; ykx[tt] = bx; yky[tt] = by;
      sq[tt] = ax * ax + ay * ay; sk[tt] = bx * bx + by * by;
      *(unsigned*)(vb + (t0 + tt) * 128 + 2 * lane) = cvtpk(cx, cy);
    }
#define RED_STEP(X) { _Pragma("unroll") for (int tt = 0; tt < 16; ++tt) { sq[tt] += lx<X>(sq[tt]); sk[tt] += lx<X>(sk[tt]); } }
    RED_STEP(1) RED_STEP(2) RED_STEP(4) RED_STEP(8) RED_STEP(16)
#pragma unroll
    for (int tt = 0; tt < 16; ++tt) {
      const float rq = rsqrtf(lx32_sum(sq[tt]) + EPSV) * 0.08838834764831845f;
      const float rk = rsqrtf(lx32_sum(sk[tt]) + EPSV);
      *(unsigned*)(qn + (t0 + tt) * 136 + 2 * lane) = cvtpk(yqx[tt] * rq, yqy[tt] * rq);
      *(unsigned*)(kn + (t0 + tt) * 136 + 2 * lane) = cvtpk(ykx[tt] * rk, yky[tt] * rk);
    }
  }
  __syncthreads();
  {
    f32x4 akk[4], aqk[4];
#pragma unroll
    for (int i = 0; i < 4; ++i) { akk[i] = f32x4{0.f, 0.f, 0.f, 0.f}; aqk[i] = f32x4{0.f, 0.f, 0.f, 0.f}; }
#pragma unroll
    for (int ks = 0; ks < 4; ++ks) {
      const bf16x8 ak = *(const bf16x8*)((const char*)kn + (16 * wave + fr) * 272 + (32 * ks + 8 * fq) * 2);
      const bf16x8 aq = *(const bf16x8*)((const char*)qn + (16 * wave + fr) * 272 + (32 * ks + 8 * fq) * 2);
#pragma unroll
      for (int nt = 0; nt < 4; ++nt) {
        if (nt <= wave) {
          const bf16x8 bk = *(const bf16x8*)((const char*)kn + (16 * nt + fr) * 272 + (32 * ks + 8 * fq) * 2);
          akk[nt] = MFMA16(ak, bk, akk[nt]);
          aqk[nt] = MFMA16(aq, bk, aqk[nt]);
        }
      }
    }
#pragma unroll
    for (int nt = 0; nt < 4; ++nt)
#pragma unroll
      for (int j = 0; j < 4; ++j) {
        const int c = 16 * wave + 4 * fq + j, s = 16 * nt + fr;
        const float dec = (s <= c) ? __expf(gcs[c] - gcs[s]) : 0.f;
        const float mv = (s < c) ? bts[c] * akk[nt][j] * dec : 0.f;
        Mb[c * 64 + s] = f2bf(-mv);
        if (nt == wave) Md[wave * 256 + (c & 15) * 16 + (s & 15)] = mv;
        Asm[c * 64 + s] = f2bf((s <= c) ? aqk[nt][j] * dec : 0.f);
      }
    {
      const float* md = Md + wave * 256;
      float t[16];
#pragma unroll
      for (int i = 0; i < 16; ++i) t[i] = (i == lane) ? 1.f : 0.f;
#pragma unroll
      for (int j = 0; j < 15; ++j)
#pragma unroll
        for (int i = j + 1; i < 16; ++i) t[i] -= md[i * 16 + j] * t[j];
      if (lane < 16) {
#pragma unroll
        for (int i = 0; i < 16; ++i) Dv[wave * 256 + i * 16 + lane] = f2bf(t[i]);
      }
    }
  }
  __syncthreads();
  {
    const float glast = gcs[63];
#pragma unroll
    for (int it = 0; it < 4; ++it) {
      const int pp = tid + 256 * it;
      const int frag = pp >> 6, l2 = pp & 63, m = l2 & 15, qq = l2 >> 4;
      {
        const int mt = frag >> 2, ks = frag & 3, row = 16 * mt + m;
        const uint2 lo = *(const uint2*)((const char*)qn + row * 272 + (32 * ks + 4 * qq) * 2);
        const uint2 hi = *(const uint2*)((const char*)qn + row * 272 + (32 * ks + 16 + 4 * qq) * 2);
        const float e = egs[row];
        uint4 o;
        o.x = cvtpk(bflo(lo.x) * e, bfhi(lo.x) * e); o.y = cvtpk(bflo(lo.y) * e, bfhi(lo.y) * e);
        o.z = cvtpk(bflo(hi.x) * e, bfhi(hi.x) * e); o.w = cvtpk(bflo(hi.y) * e, bfhi(hi.y) * e);
        *(uint4*)(dnb + DN_QG + (size_t)pp * 16) = o;
      }
      {
        const int mtk = frag >> 1, ks = frag & 1, dk = 16 * mtk + m;
        float v[8];
#pragma unroll
        for (int j = 0; j < 8; ++j) {
          const int c = 32 * ks + ((j >> 2) << 4) + 4 * qq + (j & 3);
          v[j] = bf2f(kn[c * 136 + dk]) * kds[c];
        }
        uint4 o; o.x = cvtpk(v[0], v[1]); o.y = cvtpk(v[2], v[3]); o.z = cvtpk(v[4], v[5]); o.w = cvtpk(v[6], v[7]);
        *(uint4*)(dnb + DN_KD + (size_t)pp * 16) = o;
      }
      if (it < 2) {
        const int mt = frag >> 1, ks = frag & 1, row = 16 * mt + m;
        const uint2 lo = *(const uint2*)((const char*)Asm + row * 128 + (32 * ks + 4 * qq) * 2);
        const uint2 hi = *(const uint2*)((const char*)Asm + row * 128 + (32 * ks + 16 + 4 * qq) * 2);
        *(uint4*)(dnb + DN_A + (size_t)pp * 16) = make_uint4(lo.x, lo.y, hi.x, hi.y);
      }
    }
  }
  const bool isv = wave < 2;
  f32x4 Xs[4][4];
  {
    const f32x4 z4 = f32x4{0.f, 0.f, 0.f, 0.f};
    bf16x8 dinv[4], m10, m20, m30, m31;
#pragma unroll
    for (int I = 0; I < 4; ++I) {
      const uint2 lo = *(const uint2*)(Dv + I * 256 + fr * 16 + 4 * fq);
      dinv[I] = __builtin_bit_cast(bf16x8, make_uint4(lo.x, lo.y, 0u, 0u));
    }
#define MBFRAG(I_, P_) __builtin_bit_cast(bf16x8, make_uint4(((const uint2*)(Mb + (16 * (I_) + fr) * 64 + 32 * (P_) + 4 * fq))->x, ((const uint2*)(Mb + (16 * (I_) + fr) * 64 + 32 * (P_) + 4 * fq))->y, \
                                                              ((const uint2*)(Mb + (16 * (I_) + fr) * 64 + 32 * (P_) + 16 + 4 * fq))->x, ((const uint2*)(Mb + (16 * (I_) + fr) * 64 + 32 * (P_) + 16 + 4 * fq))->y))
    m10 = MBFRAG(1, 0); m20 = MBFRAG(2, 0); m30 = MBFRAG(3, 0); m31 = MBFRAG(3, 1);
#pragma unroll
    for (int nt = 0; nt < 4; ++nt) {
      const int colx = (64 * wave + 16 * nt + fr) & 127;
      const u16* srcp = isv ? (vb + colx) : (kn + colx);
      const int sst = isv ? 128 : 136;
      f32x4 R[4];
#pragma unroll
      for (int I = 0; I < 4; ++I)
#pragma unroll
        for (int j = 0; j < 4; ++j) {
          const int row = 16 * I + 4 * fq + j;
          R[I][j] = bf2f(srcp[row * sst]) * bts[row] * (isv ? 1.f : egs[row]);
        }
      const f32x4 X0 = MFMA16(dinv[0], pack8(R[0], z4), z4);
      const f32x4 Y1 = MFMA16(m10, pack8(X0, z4), R[1]);
      const f32x4 X1 = MFMA16(dinv[1], pack8(Y1, z4), z4);
      const bf16x8 x01 = pack8(X0, X1);
      const f32x4 Y2 = MFMA16(m20, x01, R[2]);
      const f32x4 X2 = MFMA16(dinv[2], pack8(Y2, z4), z4);
      f32x4 Y3 = MFMA16(m30, x01, R[3]);
      Y3 = MFMA16(m31, pack8(X2, z4), Y3);
      const f32x4 X3 = MFMA16(dinv[3], pack8(Y3, z4), z4);
      Xs[nt][0] = X0; Xs[nt][1] = X1; Xs[nt][2] = X2; Xs[nt][3] = X3;
    }
  }
  if (isv) {
#pragma unroll
    for (int nt = 0; nt < 4; ++nt)
#pragma unroll
      for (int I = 0; I < 4; ++I) {
        uint2 o; o.x = cvtpk(Xs[nt][I][0], Xs[nt][I][1]); o.y = cvtpk(Xs[nt][I][2], Xs[nt][I][3]);
        *(uint2*)(dnb + DN_U + (size_t)(((I * 8 + 4 * wave + nt) * 64 + lane) * 8)) = o;
      }
  }
  __syncthreads();
  if (!isv) {
#pragma unroll
    for (int nt = 0; nt < 4; ++nt) {
      const int colx = (64 * wave + 16 * nt + fr) & 127;
#pragma unroll
      for (int I = 0; I < 4; ++I)
#pragma unroll
        for (int j = 0; j < 4; ++j) qn[(16 * I + 4 * fq + j) * 136 + colx] = f2bf(-Xs[nt][I][j]);
    }
  }
  __syncthreads();
#pragma unroll
  for (int it = 0; it < 4; ++it) {
    const int pp = tid + 256 * it;
    const int frag = pp >> 6, l2 = pp & 63, m = l2 & 15, qq = l2 >> 4;
    const int mt = frag >> 2, ks = frag & 3, row = 16 * mt + m;
    const uint2 lo = *(const uint2*)((const char*)qn + row * 272 + (32 * ks + 4 * qq) * 2);
    const uint2 hi = *(const uint2*)((const char*)qn + row * 272 + (32 * ks + 16 + 4 * qq) * 2);
    *(uint4*)(dnb + DN_NEGW + (size_t)pp * 16) = make_uint4(lo.x, lo.y, hi.x, hi.y);
  }
  __syncthreads();
}

constexpr size_t OUT_SN = 0;
constexpr size_t OUT_VN = 33554432;
DI void p3_scan(const Params& p, int bh, char* smem, int wv) {
  int tid_ = (wv << 6) | lane_id(); asm volatile("" : "+v"(tid_)); const int tid = tid_, wave = tid >> 6, lane = tid & 63;
  f32x4 S[8][2]; bf16x8 Sb[4][2];
#pragma unroll
  for (int i = 0; i < 8; ++i) { S[i][0] = f32x4{0.f, 0.f, 0.f, 0.f}; S[i][1] = f32x4{0.f, 0.f, 0.f, 0.f}; }
#pragma unroll
  for (int i = 0; i < 4; ++i) { Sb[i][0] = bf16x8{0, 0, 0, 0, 0, 0, 0, 0}; Sb[i][1] = bf16x8{0, 0, 0, 0, 0, 0, 0, 0}; }
  char* L = smem;
  float* egl_s = (float*)(smem + 65536);
  const unsigned char* dn0 = p.ws + OFF_DN + (size_t)(bh * 32) * DN_CHUNK_B;
  unsigned char* sn0 = (unsigned char*)p.out + OUT_SN + (size_t)(bh * 32) * 32768;
  unsigned char* vn0 = (unsigned char*)p.out + OUT_VN + (size_t)(bh * 32) * 16384;
  if (tid < 32) egl_s[tid] = __expf(((const float*)(p.ws + OFF_GLAST))[bh * 32 + tid]);
  uint4 r0, r1, r2, r3, r4, r5, r6, r7; uint2 un[8];
#define SC_NT4(p_) __builtin_bit_cast(uint4, __builtin_nontemporal_load((const f32x4*)(p_)))
#define SC_LOADC(n_) { const uint4* a_ = (const uint4*)(dn0 + (size_t)(n_) * DN_CHUNK_B + DN_NEGW) + tid; \
                       const uint4* b_ = (const uint4*)(dn0 + (size_t)(n_) * DN_CHUNK_B + DN_KD) + tid; \
                       r0 = SC_NT4(a_); r1 = SC_NT4(a_ + 256); r2 = SC_NT4(a_ + 512); r3 = SC_NT4(a_ + 768); \
                       r4 = SC_NT4(b_); r5 = SC_NT4(b_ + 256); r6 = SC_NT4(b_ + 512); r7 = SC_NT4(b_ + 768); }
#define SC_LOADU(dst, n_) { const uint2* u_ = (const uint2*)(dn0 + (size_t)(n_) * DN_CHUNK_B + DN_U) + lane; \
                            dst[0] = u_[(0 + 2 * wave) * 64]; dst[1] = u_[(0 + 2 * wave + 1) * 64]; dst[2] = u_[(8 + 2 * wave) * 64]; dst[3] = u_[(8 + 2 * wave + 1) * 64]; \
                            dst[4] = u_[(16 + 2 * wave) * 64]; dst[5] = u_[(16 + 2 * wave + 1) * 64]; dst[6] = u_[(24 + 2 * wave) * 64]; dst[7] = u_[(24 + 2 * wave + 1) * 64]; }
#define SC_STOREL(buf) { uint4* l_ = (uint4*)(L + (buf) * 32768) + tid; \
                         l_[0] = r0; l_[256] = r1; l_[512] = r2; l_[768] = r3; l_[1024] = r4; l_[1280] = r5; l_[1536] = r6; l_[1792] = r7; }
  unsigned warm = 0u;
  const unsigned char* tbase = dn0 + (wv & 1) * 8192 + (wv >> 1) * 32768;
  const unsigned char* ubase = dn0 + DN_U + (wv & 1) * 8192;
#define SC_TOUCH(n_) { const unsigned toff_ = (unsigned)lane * 128u; \
    asm volatile("global_load_dword %0, %1, %2" : "+v"(warm) : "v"(toff_), "s"(tbase + (size_t)(n_) * DN_CHUNK_B) : "memory"); \
    asm volatile("global_load_dword %0, %1, %2" : "+v"(warm) : "v"(toff_), "s"(ubase + (size_t)(n_) * DN_CHUNK_B) : "memory"); }
  SC_TOUCH(2); SC_TOUCH(3); SC_TOUCH(4);
  SC_LOADC(0); SC_LOADU(un, 0); SC_STOREL(0);
  __syncthreads();
  SC_LOADC(1);
  for (int n = 0; n < 32; ++n) {
    const char* B = L + (n & 1) * 32768 + lane * 16;
    if (n + 5 < 32) SC_TOUCH(n + 5);
    f32x4 av[4][2];
#pragma unroll
    for (int mt = 0; mt < 4; ++mt)
#pragma unroll
      for (int nt = 0; nt < 2; ++nt) { const uint2 u2 = un[mt * 2 + nt]; av[mt][nt] = f32x4{bflo(u2.x), bfhi(u2.x), bflo(u2.y), bfhi(u2.y)}; }
    if (n + 1 < 32) SC_LOADU(un, n + 1);
#pragma unroll
    for (int mt = 0; mt < 4; ++mt)
#pragma unroll
      for (int ks = 0; ks < 4; ++ks) {
        const bf16x8 af = *(const bf16x8*)(B + (mt * 4 + ks) * 1024);
        av[mt][0] = MFMA16(af, Sb[ks][0], av[mt][0]);
        av[mt][1] = MFMA16(af, Sb[ks][1], av[mt][1]);
      }
    bf16x8 vbf[2][2];
#pragma unroll
    for (int k2 = 0; k2 < 2; ++k2)
#pragma unroll
      for (int nt = 0; nt < 2; ++nt) vbf[k2][nt] = pack8(av[2 * k2][nt], av[2 * k2 + 1][nt]);
    {
      unsigned char* sn = sn0 + (size_t)n * 32768 + lane * 16;
      unsigned char* vn = vn0 + (size_t)n * 16384 + lane * 16;
#pragma unroll
      for (int ks = 0; ks < 4; ++ks)
#pragma unroll
        for (int nt = 0; nt < 2; ++nt) *(bf16x8*)(sn + (ks * 8 + 2 * wave + nt) * 1024) = Sb[ks][nt];
#pragma unroll
      for (int k2 = 0; k2 < 2; ++k2)
#pragma unroll
        for (int nt = 0; nt < 2; ++nt) *(bf16x8*)(vn + (k2 * 8 + 2 * wave + nt) * 1024) = vbf[k2][nt];
    }
    const float egl = egl_s[n];
#pragma unroll
    for (int mk = 0; mk < 8; ++mk) {
#pragma unroll
      for (int nt = 0; nt < 2; ++nt) { S[mk][nt][0] *= egl; S[mk][nt][1] *= egl; S[mk][nt][2] *= egl; S[mk][nt][3] *= egl; }
#pragma unroll
      for (int k2 = 0; k2 < 2; ++k2) {
        const bf16x8 af = *(const bf16x8*)(B + 16384 + (mk * 2 + k2) * 1024);
        S[mk][0] = MFMA16(af, vbf[k2][0], S[mk][0]);
        S[mk][1] = MFMA16(af, vbf[k2][1], S[mk][1]);
      }
    }
#pragma unroll
    for (int ks = 0; ks < 4; ++ks)
#pragma unroll
      for (int nt = 0; nt < 2; ++nt) Sb[ks][nt] = pack8(S[2 * ks][nt], S[2 * ks + 1][nt]);
    if (n + 1 < 32) SC_STOREL((n + 1) & 1);
    if (n + 2 < 32) SC_LOADC(n + 2);
    __syncthreads();
  }
  asm volatile("s_waitcnt vmcnt(0)" ::: "memory");
  asm volatile("" :: "v"(warm));
  __syncthreads();
  if (tid == 0) {
    __builtin_amdgcn_fence(__ATOMIC_RELEASE, "agent");
    asm volatile("s_waitcnt vmcnt(0)" ::: "memory");
    __hip_atomic_store((unsigned*)(p.ws + OFF_CTR) + 128 + bh, 1u, __ATOMIC_RELAXED, __HIP_MEMORY_SCOPE_AGENT);
  }
}

DI void p4_dnout(const Params& p, int ci, char* smem, int wv) {
  int tid_ = (wv << 6) | lane_id(); asm volatile("" : "+v"(tid_)); const int tid = tid_, wave = tid >> 6, lane = tid & 63, fr = lane & 15, fq = lane >> 4;
  const int n = ci & 31, h = (ci >> 5) & 3, b = ci >> 7;
  float* rd = (float*)smem;
  const unsigned char* base = p.ws + OFF_DN + (size_t)ci * DN_CHUNK_B;
  const uint4* qg = (const uint4*)(base + DN_QG) + lane;
  const uint4* aa = (const uint4*)(base + DN_A) + lane;
  const unsigned char* sn = (const unsigned char*)p.out + OUT_SN + (size_t)ci * 32768 + lane * 16;
  const unsigned char* vn = (const unsigned char*)p.out + OUT_VN + (size_t)ci * 16384 + lane * 16;
  bf16x8 Sb[4][2], vbf[2][2];
#pragma unroll
  for (int ks = 0; ks < 4; ++ks)
#pragma unroll
    for (int nt = 0; nt < 2; ++nt) Sb[ks][nt] = *(const bf16x8*)(sn + (ks * 8 + 2 * wave + nt) * 1024);
#pragma unroll
  for (int k2 = 0; k2 < 2; ++k2)
#pragma unroll
    for (int nt = 0; nt < 2; ++nt) vbf[k2][nt] = *(const bf16x8*)(vn + (k2 * 8 + 2 * wave + nt) * 1024);
  f32x4 ao[4][2];
#pragma unroll
  for (int mt = 0; mt < 4; ++mt) {
    ao[mt][0] = f32x4{0.f, 0.f, 0.f, 0.f}; ao[mt][1] = f32x4{0.f, 0.f, 0.f, 0.f};
#pragma unroll
    for (int ks = 0; ks < 4; ++ks) {
      const bf16x8 af = __builtin_bit_cast(bf16x8, qg[(mt * 4 + ks) * 64]);
      ao[mt][0] = MFMA16(af, Sb[ks][0], ao[mt][0]);
      ao[mt][1] = MFMA16(af, Sb[ks][1], ao[mt][1]);
    }
#pragma unroll
    for (int k2 = 0; k2 < 2; ++k2) {
      const bf16x8 af = __builtin_bit_cast(bf16x8, aa[(mt * 2 + k2) * 64]);
      ao[mt][0] = MFMA16(af, vbf[k2][0], ao[mt][0]);
      ao[mt][1] = MFMA16(af, vbf[k2][1], ao[mt][1]);
    }
  }
  float gn[2];
  gn[0] = p.dn_out_gain[32 * wave + fr]; gn[1] = p.dn_out_gain[32 * wave + 16 + fr];
  const u16* proj = (const u16*)(p.ws + OFF_PROJ);
  u16* mixed = (u16*)(p.ws + OFF_HB);
#pragma unroll
  for (int mt = 0; mt < 4; ++mt)
#pragma unroll
    for (int j = 0; j < 4; ++j) {
      float s = ao[mt][0][j] * ao[mt][0][j] + ao[mt][1][j] * ao[mt][1][j];
      s += lx<1>(s); s += lx<2>(s); s += lx<4>(s); s += lx<8>(s);
      if (fr == 0) rd[wave * 64 + 16 * mt + 4 * fq + j] = s;
    }
  __syncthreads();
#pragma unroll
  for (int mt = 0; mt < 4; ++mt)
#pragma unroll
    for (int j = 0; j < 4; ++j) {
      const int c = 16 * mt + 4 * fq + j;
      const float tot = rd[c] + rd[64 + c] + rd[128 + c] + rd[192 + c];
      const float rstd = rsqrtf(tot * (1.f / 128.f) + EPSV);
      const size_t tok = (size_t)b * SEQ + n * 64 + c;
#pragma unroll
      for (int nt = 0; nt < 2; ++nt) {
        const int dv = 32 * wave + 16 * nt + fr;
        const float z = bf2f(proj[tok * NP + C_DNZ + h * 128 + dv]);
        mixed[tok * 1024 + h * 128 + dv] = f2bf(ao[mt][nt][j] * rstd * gn[nt] * silu_f(z));
      }
    }
  __syncthreads();
}

DI void p3_attn(const Params& p, int bh, int qb, char* smem, int wv) {
  int tid_ = (wv << 6) | lane_id(); asm volatile("" : "+v"(tid_)); const int tid = tid_, wave = tid >> 6, lane = tid & 63, fr = lane & 15, fq = lane >> 4;
  const int b = bh >> 2, h = bh & 3;
  char* Ks = smem; char* Vs = smem + 32768;
  const u16* proj = (const u16*)(p.ws + OFF_PROJ);
  const size_t tokb = (size_t)b * SEQ;
  const int qrow = qb * 64 + 16 * wave + fr;
  bf16x8 qf[2][2];
#pragma unroll
  for (int mp = 0; mp < 2; ++mp)
#pragma unroll
    for (int ks = 0; ks < 2; ++ks) qf[mp][ks] = __builtin_bit_cast(bf16x8, __builtin_nontemporal_load((const f32x4*)(proj + (tokb + qrow) * NP + C_DFQ + h * 128 + mp * 64 + 32 * ks + 8 * fq)));
  f32x4 O[2][8];
#pragma unroll
  for (int mp = 0; mp < 2; ++mp)
#pragma unroll
    for (int i = 0; i < 8; ++i) O[mp][i] = f32x4{0.f, 0.f, 0.f, 0.f};
  float mrun[2] = {-INFINITY, -INFINITY}, lrun[2] = {0.f, 0.f};
  const int ntiles = qb + 1;
  const int srow = tid >> 4, c16 = tid & 15;
  const int koff = srow * 256 + ((c16 ^ (srow & 15)) << 4);
  const int voff = srow * 256 + (((c16 >> 1) ^ (srow & 7)) << 5) + ((c16 & 1) << 4);
  const u16* kg = proj + (tokb + srow) * NP + C_DFK + h * 128 + c16 * 8;
  const u16* vg = proj + (tokb + srow) * NP + C_DFV + h * 128 + c16 * 8;
  uint4 rk[4], rv[4];
#pragma unroll
  for (int i = 0; i < 4; ++i) { rk[i] = *(const uint4*)(kg + (size_t)(16 * i) * NP); rv[i] = *(const uint4*)(vg + (size_t)(16 * i) * NP); }
#pragma unroll
  for (int i = 0; i < 4; ++i) { *(uint4*)(Ks + koff + i * 4096) = rk[i]; *(uint4*)(Vs + voff + i * 4096) = rv[i]; }
  __syncthreads();
  const int trr = fr >> 2, trp = fr & 3;
  for (int kt = 0; kt < ntiles; ++kt) {
    const int buf = (kt & 1) * 16384;
    if (kt + 1 < ntiles) {
#pragma unroll
      for (int i = 0; i < 4; ++i) {
        rk[i] = *(const uint4*)(kg + (size_t)((kt + 1) * 64 + 16 * i) * NP);
        rv[i] = *(const uint4*)(vg + (size_t)((kt + 1) * 64 + 16 * i) * NP);
      }
    }
    f32x4 st[2][4];
#pragma unroll
    for (int mp = 0; mp < 2; ++mp)
#pragma unroll
      for (int mt = 0; mt < 4; ++mt) {
        st[mp][mt] = f32x4{0.f, 0.f, 0.f, 0.f};
#pragma unroll
        for (int ks = 0; ks < 2; ++ks) {
          const bf16x8 ka = *(const bf16x8*)(Ks + buf + (16 * mt + fr) * 256 + (((mp * 8 + ks * 4 + fq) ^ fr) << 4));
          st[mp][mt] = MFMA16(ka, qf[mp][ks], st[mp][mt]);
        }
      }
    if (kt == qb) {
#pragma unroll
      for (int mt = 0; mt < 4; ++mt)
#pragma unroll
        for (int j = 0; j < 4; ++j) {
          const int key = kt * 64 + 16 * mt + 4 * fq + j;
          if (key > qrow) { st[0][mt][j] = -INFINITY; st[1][mt][j] = -INFINITY; }
        }
    }
    bf16x8 pf[2][2];
#pragma unroll
    for (int mp = 0; mp < 2; ++mp) {
      float mx = st[mp][0][0];
#pragma unroll
      for (int mt = 0; mt < 4; ++mt)
#pragma unroll
        for (int j = 0; j < 4; ++j) mx = fmaxf(mx, st[mp][mt][j]);
      mx = fmaxf(mx, lx<16>(mx)); mx = lx32_max(mx);
      const float mnew = fmaxf(mrun[mp], mx);
      const float alpha = __builtin_amdgcn_exp2f(mrun[mp] - mnew);
      mrun[mp] = mnew;
      float ps = 0.f;
#pragma unroll
      for (int mt = 0; mt < 4; ++mt)
#pragma unroll
        for (int j = 0; j < 4; ++j) { const float e = __builtin_amdgcn_exp2f(st[mp][mt][j] - mnew); st[mp][mt][j] = e; ps += e; }
      lrun[mp] = lrun[mp] * alpha + ps;
      if (__builtin_amdgcn_ballot_w64(alpha != 1.f) != 0ull) {
#pragma unroll
        for (int i = 0; i < 8; ++i) { O[mp][i][0] *= alpha; O[mp][i][1] *= alpha; O[mp][i][2] *= alpha; O[mp][i][3] *= alpha; }
      }
      pf[mp][0] = pack8(st[mp][0], st[mp][1]);
      pf[mp][1] = pack8(st[mp][2], st[mp][3]);
    }
#pragma unroll
    for (int k2 = 0; k2 < 2; ++k2) {
      const int r0 = 32 * k2 + 4 * fq + trr, r1 = r0 + 16;
#pragma unroll
      for (int mv = 0; mv < 8; ++mv) {
        const s16x4 lo = vtr(Vs + buf + r0 * 256 + ((mv ^ (r0 & 7)) << 5) + 8 * trp);
        const s16x4 hi = vtr(Vs + buf + r1 * 256 + ((mv ^ (r1 & 7)) << 5) + 8 * trp);
        const bf16x8 va = __builtin_shufflevector(lo, hi, 0, 1, 2, 3, 4, 5, 6, 7);
        O[0][mv] = MFMA16(va, pf[0][k2], O[0][mv]);
        O[1][mv] = MFMA16(va, pf[1][k2], O[1][mv]);
      }
    }
    if (kt + 1 < ntiles) {
      const int nb = ((kt + 1) & 1) * 16384;
#pragma unroll
      for (int i = 0; i < 4; ++i) { *(uint4*)(Ks + nb + koff + i * 4096) = rk[i]; *(uint4*)(Vs + nb + voff + i * 4096) = rv[i]; }
    }
    __syncthreads();
  }
  int tid2 = (wv << 6) | lane_id(); asm volatile("" : "+v"(tid2));
  const int qrow_e = qb * 64 + 16 * (tid2 >> 6) + (tid2 & 15), fq_e = (tid2 >> 4) & 3;
  float inv[2];
#pragma unroll
  for (int mp = 0; mp < 2; ++mp) { float l = lrun[mp]; l += lx<16>(l); l = lx32_sum(l); inv[mp] = 1.f / l; }
  const float li = *(const float*)(smem + 73744) * inv[1];
  float ss = 0.f;
#pragma unroll
  for (int mv = 0; mv < 8; ++mv)
#pragma unroll
    for (int j = 0; j < 4; ++j) { const float o = O[0][mv][j] * inv[0] - li * O[1][mv][j]; O[0][mv][j] = o; ss += o * o; }
  ss += lx<16>(ss); ss = lx32_sum(ss);
  const float rstd = rsqrtf(ss * (1.f / 128.f) + EPSV) * 0.8f;
  u16* mixed = (u16*)(p.ws + OFF_HB);
#pragma unroll
  for (int mv = 0; mv < 8; ++mv) {
    const int dv = 16 * mv + 4 * fq_e;
    typedef unsigned u32x2 __attribute__((ext_vector_type(2)));
    const u32x2 zz_ = __builtin_nontemporal_load((const u32x2*)(proj + (tokb + qrow_e) * NP + C_DFZ + h * 128 + dv));
    const uint2 zz = make_uint2(zz_[0], zz_[1]);
    const float4 g4 = *(const float4*)(p.df_out_gain + dv);
    uint2 o;
    o.x = cvtpk(O[0][mv][0] * rstd * g4.x * silu_f(bflo(zz.x)), O[0][mv][1] * rstd * g4.y * silu_f(bfhi(zz.x)));
    o.y = cvtpk(O[0][mv][2] * rstd * g4.z * silu_f(bflo(zz.y)), O[0][mv][3] * rstd * g4.w * silu_f(bfhi(zz.y)));
    *(uint2*)(mixed + (tokb + qrow_e) * 1024 + 512 + h * 128 + dv) = o;
  }
}

#define XB_TMO      128
#define XB_XCNT(j)  (256  + 64 * (j))
#define XB_XSUB(j)  (1280 + 64 * (j))
#define XB_XGEN(j)  (2304 + 64 * (j))
#define XB_TOP      3328
#define XB_TOPGEN   3392
#define XCD_BAR_WORDS 3456
#define XB_SPIN_CAP (1u << 18)
#define LAS __attribute__((address_space(3)))
DI unsigned xb_ld(unsigned* p) { return __hip_atomic_load(p, __ATOMIC_RELAXED, __HIP_MEMORY_SCOPE_AGENT); }
DI unsigned xb_add(unsigned* p, unsigned v) { return __hip_atomic_fetch_add(p, v, __ATOMIC_RELAXED, __HIP_MEMORY_SCOPE_AGENT); }
DI unsigned xb_xcc_id() { return (unsigned)__builtin_amdgcn_s_getreg((3 << 11) | 20) & 0xFu; }
#define XB_SPIN(cond, bar) do { unsigned _sp = 0; while (cond) { __builtin_amdgcn_s_sleep(1); \
    if ((++_sp & 255u) == 0u) { if (xb_ld(&(bar)[XB_TMO])) break; if (_sp > XB_SPIN_CAP) { atomicAdd(&(bar)[XB_TMO], 1u); break; } } } } while (0)
DI void xcd_barrier_complete(unsigned* bar, unsigned x, unsigned& nloc, unsigned& nx) {
  const unsigned G = gridDim.x;
  unsigned sum, cnt, mine, sp = 0u;
  for (;;) {
    sum = 0u; cnt = 0u; mine = 0u;
#pragma unroll
    for (unsigned j = 0; j < 16; ++j) { const unsigned c = xb_ld(&bar[XB_XCNT(j)]); sum += c; cnt += (c > 0u) ? 1u : 0u; mine = (j == x) ? c : mine; }
    if (sum == G) break;
    __builtin_amdgcn_s_sleep(1);
    if ((++sp & 255u) == 0u) { if (xb_ld(&bar[XB_TMO])) break; if (sp > XB_SPIN_CAP) { atomicAdd(&bar[XB_TMO], 1u); break; } }
  }
  nloc = mine > 0u ? mine : 1u; nx = cnt > 0u ? cnt : 1u;
}
DI void xcd_barrier(unsigned* bar, volatile LAS unsigned* st, bool leader) {
  asm volatile("s_waitcnt vmcnt(0)" ::: "memory");
  __syncthreads();
  if (leader) {
    const unsigned x = xb_xcc_id();
    __builtin_amdgcn_s_waitcnt(0);
    unsigned nloc = st[0], nx = st[1];
    if (nloc == 0u) { xcd_barrier_complete(bar, x, nloc, nx); st[0] = nloc; st[1] = nx; }
    const unsigned old = xb_add(&bar[XB_XSUB(x)], 1u);
    const unsigned gen = old / nloc;
    if (old + 1u == (gen + 1u) * nloc) {
      __builtin_amdgcn_fence(__ATOMIC_RELEASE, "agent");
      asm volatile("s_waitcnt vmcnt(0)" ::: "memory");
      const unsigned og = xb_add(&bar[XB_TOP], 1u);
      const unsigned tg = og / nx;
      if (og + 1u == (tg + 1u) * nx) xb_add(&bar[XB_TOPGEN], 1u);
      else XB_SPIN(xb_ld(&bar[XB_TOPGEN]) == tg, bar);
      __builtin_amdgcn_fence(__ATOMIC_ACQUIRE, "agent");
      xb_add(&bar[XB_XGEN(x)], 1u);
      asm volatile("s_waitcnt vmcnt(0)" ::: "memory");
    } else {
      XB_SPIN(xb_ld(&bar[XB_XGEN(x)]) == gen, bar);
      __builtin_amdgcn_fence(__ATOMIC_ACQUIRE, "agent");
      asm volatile("s_waitcnt vmcnt(0)" ::: "memory");
    }
  }
  __syncthreads();
}

template <int ONLY>
__global__ void __launch_bounds__(256, 2) fwd_kernel(Params p) {
  __shared__ __attribute__((aligned(16))) char smem[SMEM_BYTES];
  const int nb = gridDim.x, bid = blockIdx.x;
  const int wv = __builtin_amdgcn_readfirstlane((int)(threadIdx.x >> 6));
  __shared__ uint4 xb_words;
  unsigned* const gbar = (unsigned*)(p.ws + OFF_BAR);
  volatile LAS unsigned* const xst = (volatile LAS unsigned*)&xb_words;
  if (ONLY < 0) {
    if (wv == 0 && lane_id() == 0) { xb_words = make_uint4(0u, 0u, 0u, 0u); (void)xb_add(&gbar[XB_XCNT(xb_xcc_id())], 1u); }
    __syncthreads();
    if (p.coop == 2) cg::this_grid().sync();
  }
#define GRID_SYNC() xcd_barrier(gbar, xst, wv == 0 && lane_id() == 0)
  if (ONLY < 0 || ONLY == 0) {
    if (bid == 0 && wv < 3) ((unsigned*)(p.ws + OFF_CTR))[(wv << 6) | lane_id()] = 0u;
    for (int it = bid; it < 1024 + 256; it += nb) {
      if (it < 1024) p0_transpose(p.w_in, WIN_LD, true, (u16*)(p.ws + OFF_WTIN), it & 15, it >> 4, smem, wv);
      else { const int t = it - 1024; p0_transpose(p.w_out, 1024, false, (u16*)(p.ws + OFF_WTOUT), t & 15, t >> 4, smem, wv); }
    }
    p0_fill_w8(p, smem, wv);
    __syncthreads();
    for (int it = bid; it < 4096; it += nb) p0_rows(p, it, smem, wv);
    __syncthreads();
  }
  if (ONLY < 0) GRID_SYNC();
  if (ONLY < 0 || ONLY == 1) {
    for (int rep = 0; rep < REP_G1; ++rep)
    for (int it = bid; it < 4096; it += nb)
      gemm_tile<1>(p, (const u16*)(p.ws + OFF_HB), (const u16*)(p.ws + OFF_WTIN), (it >> 5) * 128, (it & 31) * 128, smem, wv);
  }
  if (ONLY < 0) GRID_SYNC();
  if (ONLY < 0 || ONLY == 2) {
    for (int l = bid >> 3; l < 128; l += (nb >> 3)) p2_prep(p, (bid & 7) * 128 + l, smem, wv);
#if REP_PREP > 1
    for (int it = bid; it < 1024; it += nb) p2_prep(p, it, smem, wv);
#endif
  }
  if (ONLY < 0) GRID_SYNC();
  if (ONLY < 0 || ONLY == 3) {
    const int lane = lane_id();
    const float s1 = wave_sum(p.lq1[lane] * p.lk1[lane]), s2 = wave_sum(p.lq2[lane] * p.lk2[lane]);
    if (wv == 0 && lane == 0) *(float*)(smem + 73744) = __expf(s1) - __expf(s2) + 0.2f;
    __syncthreads();
    if (bid < 32) p3_scan(p, (bid & 7) * 4 + (bid >> 3), smem, wv);
    int* slot = (int*)(smem + 73728);
    const int xcc = bid & 7;
    for (int qi = 0; qi < 8; ++qi) {
      const int qx = (xcc + qi) & 7;
      unsigned* ctr = (unsigned*)(p.ws + OFF_CTR) + qx * 16;
      while (true) {
        if (wv == 0 && lane == 0) *slot = (int)atomicAdd(ctr, 1u);
        __syncthreads();
        const int it = *slot;
        __syncthreads();
        if (it >= 256) break;
        if (it < 128) {
          p3_attn(p, qx * 4 + (it & 3), 31 - (it >> 2), smem, wv);
        } else {
          const int bh = qx * 4 + (it & 3);
          if (wv == 0 && lane == 0) {
            unsigned* fl = (unsigned*)(p.ws + OFF_CTR) + 128 + bh;
            while (__hip_atomic_load(fl, __ATOMIC_RELAXED, __HIP_MEMORY_SCOPE_AGENT) == 0u) __builtin_amdgcn_s_sleep(2);
            __builtin_amdgcn_fence(__ATOMIC_ACQUIRE, "agent");
            asm volatile("s_waitcnt vmcnt(0)" ::: "memory");
          }
          __syncthreads();
          p4_dnout(p, bh * 32 + ((it - 128) >> 2), smem, wv);
        }
      }
    }
  }
  if (ONLY < 0) GRID_SYNC();
  if (ONLY < 0 || ONLY == 5) {
    for (int it = bid; it < 1024; it += nb) {
      const int xq = it & 7, s = it >> 3;
      gemm_tile<2>(p, (const u16*)(p.ws + OFF_HB), (const u16*)(p.ws + OFF_WTOUT), (xq * 16 + (s >> 3)) * 128, (s & 7) * 128, smem, wv);
    }
  }
}

extern "C" void kernel_launch(void* const* d_in, const int* in_sizes, int n_in, void* d_out, int out_size, void* d_ws, size_t ws_size,
                              hipStream_t stream) {
  Params p{};
  p.x = (const float*)d_in[0]; p.norm_gain = (const float*)d_in[1]; p.w_in = (const float*)d_in[2]; p.conv_w = (const float*)d_in[3];
  p.a_log = (const float*)d_in[4]; p.dt_bias = (const float*)d_in[5]; p.dn_out_gain = (const float*)d_in[6]; p.q_gain = (const float*)d_in[7];
  p.k_gain = (const float*)d_in[8]; p.lq1 = (const float*)d_in[9]; p.lk1 = (const float*)d_in[10]; p.lq2 = (const float*)d_in[11];
  p.lk2 = (const float*)d_in[12]; p.df_out_gain = (const float*)d_in[13]; p.w_out = (const float*)d_in[14];
  p.out = (float*)d_out; p.ws = (unsigned char*)d_ws;
  static int grid_blocks = 0;
  if (!grid_blocks) {
    int dev = 0, cus = 0, per_cu = 0;
    (void)hipGetDevice(&dev);
    (void)hipDeviceGetAttribute(&cus, hipDeviceAttributeMultiprocessorCount, dev);
#if USE_COOP
    (void)hipOccupancyMaxActiveBlocksPerMultiprocessor(&per_cu, fwd_kernel<-1>, 256, 0);
#else
    per_cu = 2;
#endif
    if (per_cu > 2) per_cu = 2;
    if (per_cu < 1) per_cu = 1;
    grid_blocks = cus * per_cu;
  }
#if USE_COOP
  (void)hipMemsetAsync((unsigned char*)d_ws + OFF_BAR, 0, 3456 * 4, stream);
  p.phase_lo = 0; p.phase_hi = 5; p.coop = 1;
  void* args[] = {&p};
  hipError_t e = hipLaunchCooperativeKernel((void*)fwd_kernel<-1>, dim3(grid_blocks), dim3(256), args, 0, stream);
  if (e != hipSuccess) fprintf(stderr, "cooperative launch failed: %s (grid %d)\n", hipGetErrorString(e), grid_blocks);
#else
  p.coop = 0;
  p.phase_lo = 0; p.phase_hi = 1; hipLaunchKernelGGL(fwd_kernel<0>, dim3(grid_blocks), dim3(256), 0, stream, p);
  p.phase_lo = 1; p.phase_hi = 2; hipLaunchKernelGGL(fwd_kernel<1>, dim3(grid_blocks), dim3(256), 0, stream, p);
  p.phase_lo = 2; p.phase_hi = 3; hipLaunchKernelGGL(fwd_kernel<2>, dim3(grid_blocks), dim3(256), 0, stream, p);
  p.phase_lo = 3; p.phase_hi = 4; hipLaunchKernelGGL(fwd_kernel<3>, dim3(grid_blocks), dim3(256), 0, stream, p);
  p.phase_lo = 4; p.phase_hi = 5; hipLaunchKernelGGL(fwd_kernel<4>, dim3(grid_blocks), dim3(256), 0, stream, p);
  p.phase_lo = 5; p.phase_hi = 6; hipLaunchKernelGGL(fwd_kernel<5>, dim3(grid_blocks), dim3(256), 0, stream, p);
#endif
}
```

```cpp
#include <hip/hip_runtime.h>
#include <hip/hip_cooperative_groups.h>
#include <cstdio>
#include <cstdint>
namespace cg = cooperative_groups;

#ifndef REP_P0
#define REP_P0 1
#endif
#ifndef REP_DNOUT
#define REP_DNOUT 1
#endif
#ifndef REP_G1
#define REP_G1 1
#endif
#ifndef REP_PREP
#define REP_PREP 1
#endif
#ifndef REP_SCAN
#define REP_SCAN 1
#endif
#ifndef REP_ATTN
#define REP_ATTN 1
#endif
#ifndef USE_COOP
#define USE_COOP 1
#endif

#define DI __device__ __forceinline__
typedef __attribute__((ext_vector_type(8))) short bf16x8;
typedef __attribute__((ext_vector_type(4))) short s16x4;
typedef __attribute__((ext_vector_type(4))) float f32x4;
typedef short v4i16_t __attribute__((ext_vector_type(4)));
typedef __attribute__((address_space(3))) const char* lds_cptr;
typedef unsigned short u16;

constexpr int SEQ = 2048, NTOK = 16384, DMODEL = 1024, NP = 4096, WIN_LD = 4104;
constexpr int C_DNQ = 0, C_DNK = 512, C_DNV = 1024, C_DNZ = 1536, C_DFQ = 2048, C_DFK = 2560, C_DFV = 3072, C_DFZ = 3584;
constexpr float EPSV = 1e-6f;
constexpr float LOG2E = 1.4426950408889634f;

constexpr size_t OFF_PROJ = 0;
constexpr size_t OFF_HB = 134217728;
constexpr size_t OFF_WTIN = OFF_HB + 33554432;
constexpr size_t OFF_WTOUT = OFF_WTIN + 8388608;
constexpr size_t OFF_G = OFF_WTOUT + 2097152;
constexpr size_t OFF_BETA = OFF_G + 262144;
constexpr size_t OFF_DN = OFF_BETA + 262144;
constexpr size_t DN_CHUNK_B = 73728;
constexpr size_t DN_NEGW = 0, DN_QG = 16384, DN_KD = 32768, DN_A = 49152, DN_U = 57344;
constexpr size_t OFF_GLAST = OFF_DN + DN_CHUNK_B * 1024;
constexpr size_t OFF_CTR = OFF_GLAST + 4096;
constexpr size_t OFF_BAR = OFF_CTR + 1024;

constexpr int SMEM_BYTES = 77824;

struct Params {
  const float *x, *norm_gain, *w_in, *conv_w, *a_log, *dt_bias, *dn_out_gain, *q_gain, *k_gain;
  const float *lq1, *lk1, *lq2, *lk2, *df_out_gain, *w_out;
  float* out;
  unsigned char* ws;
  int phase_lo, phase_hi, coop, pad0;
};

typedef __bf16 bf16x2_t __attribute__((ext_vector_type(2)));
DI unsigned cvtpk(float lo, float hi) { bf16x2_t v; v[0] = (__bf16)lo; v[1] = (__bf16)hi; return __builtin_bit_cast(unsigned, v); }
DI float bf2f(u16 h) { return __uint_as_float(((unsigned)h) << 16); }
DI float bflo(unsigned u) { return __uint_as_float(u << 16); }
DI float bfhi(unsigned u) { return __uint_as_float(u & 0xffff0000u); }
DI u16 f2bf(float x) { return (u16)(cvtpk(x, 0.f) & 0xffffu); }
template <int X> DI float lx(float v) { return __builtin_bit_cast(float, __builtin_amdgcn_ds_swizzle(__builtin_bit_cast(int, v), 0x1f | (X << 10))); }
DI float lx32_sum(float v) { auto rr = __builtin_amdgcn_permlane32_swap(__float_as_uint(v), __float_as_uint(v), false, false); return __uint_as_float(rr[0]) + __uint_as_float(rr[1]); }
DI float lx32_max(float v) { auto rr = __builtin_amdgcn_permlane32_swap(__float_as_uint(v), __float_as_uint(v), false, false); return fmaxf(__uint_as_float(rr[0]), __uint_as_float(rr[1])); }
DI float wave_sum(float v) {
  v += lx<1>(v); v += lx<2>(v); v += lx<4>(v); v += lx<8>(v); v += lx<16>(v);
  return lx32_sum(v);
}
DI int lane_id() { int l; asm volatile("v_mbcnt_lo_u32_b32 %0, -1, 0\n\tv_mbcnt_hi_u32_b32 %0, -1, %0" : "=v"(l)); return l; }
DI float silu_f(float y) { return y * __builtin_amdgcn_rcpf(1.f + __expf(-y)); }
DI s16x4 vtr(const char* p) { return __builtin_bit_cast(s16x4, __builtin_amdgcn_ds_read_tr16_b64_v4i16((__attribute__((address_space(3))) v4i16_t*)(lds_cptr)p)); }
#define MFMA16(a, b, c) __builtin_amdgcn_mfma_f32_16x16x32_bf16((a), (b), (c), 0, 0, 0)
DI bf16x8 pack8(const f32x4& a, const f32x4& b) {
  uint4 u; u.x = cvtpk(a[0], a[1]); u.y = cvtpk(a[2], a[3]); u.z = cvtpk(b[0], b[1]); u.w = cvtpk(b[2], b[3]);
  return __builtin_bit_cast(bf16x8, u);
}

DI void p0_fill_w8(const Params& p, char* smem, int wv) {
  int tid_ = (wv << 6) | lane_id(); asm volatile("" : "+v"(tid_)); const int tid = tid_;
  float4* pl = (float4*)smem;
#pragma unroll
  for (int j = 0; j < 8; ++j) {
    const int q = tid + 256 * j, k = q >> 1, c4 = q & 1;
    pl[(c4 * 4 + (k & 3)) * 256 + (k >> 2)] = *(const float4*)(p.w_in + (size_t)k * WIN_LD + 2048 + 4 * c4);
  }
}
DI void p0_rows(const Params& p, int item, char* smem, int wv) {
  int tid_ = (wv << 6) | lane_id(); asm volatile("" : "+v"(tid_)); const int tid = tid_, wave = tid >> 6, lane = tid & 63;
  const int row = item * 4 + wave;
  const float4* pl = (const float4*)smem;
  const float4* xr = (const float4*)(p.x + (size_t)row * 1024);
  float4 xv[4]; float ss = 0.f;
  float acc[8];
#pragma unroll
  for (int j = 0; j < 8; ++j) acc[j] = 0.f;
#pragma unroll
  for (int i = 0; i < 4; ++i) {
    { const f32x4 t4 = __builtin_nontemporal_load((const f32x4*)xr + lane + 64 * i); xv[i] = make_float4(t4[0], t4[1], t4[2], t4[3]); }
    const float4 g = ((const float4*)p.norm_gain)[lane + 64 * i];
    ss += xv[i].x * xv[i].x + xv[i].y * xv[i].y + xv[i].z * xv[i].z + xv[i].w * xv[i].w;
    xv[i].x *= g.x; xv[i].y *= g.y; xv[i].z *= g.z; xv[i].w *= g.w;
    const float hh[4] = {xv[i].x, xv[i].y, xv[i].z, xv[i].w};
#pragma unroll
    for (int e = 0; e < 4; ++e) {
      const float4 w0 = pl[(0 + e) * 256 + lane + 64 * i], w1 = pl[(4 + e) * 256 + lane + 64 * i];
      acc[0] += hh[e] * w0.x; acc[1] += hh[e] * w0.y; acc[2] += hh[e] * w0.z; acc[3] += hh[e] * w0.w;
      acc[4] += hh[e] * w1.x; acc[5] += hh[e] * w1.y; acc[6] += hh[e] * w1.z; acc[7] += hh[e] * w1.w;
    }
  }
  ss = wave_sum(ss);
#pragma unroll
  for (int j = 0; j < 8; ++j) acc[j] = wave_sum(acc[j]);
  const float rstd = rsqrtf(ss * (1.f / 1024.f) + EPSV);
  u16* hb = (u16*)(p.ws + OFF_HB);
#pragma unroll
  for (int i = 0; i < 4; ++i) {
    uint2 pk; pk.x = cvtpk(xv[i].x * rstd, xv[i].y * rstd); pk.y = cvtpk(xv[i].z * rstd, xv[i].w * rstd);
    *(uint2*)(hb + (size_t)row * 1024 + (lane + 64 * i) * 4) = pk;
  }
  if (lane < 8) {
    float v = acc[0];
    v = lane == 1 ? acc[1] : v; v = lane == 2 ? acc[2] : v; v = lane == 3 ? acc[3] : v;
    v = lane == 4 ? acc[4] : v; v = lane == 5 ? acc[5] : v; v = lane == 6 ? acc[6] : v; v = lane == 7 ? acc[7] : v;
    v *= rstd;
    const int hd = lane & 3;
    if (lane < 4) {
      ((float*)(p.ws + OFF_BETA))[row * 4 + hd] = 1.f / (1.f + expf(-v));
    } else {
      const float a = v + p.dt_bias[hd];
      const float sp = fmaxf(a, 0.f) + log1pf(expf(-fabsf(a)));
      ((float*)(p.ws + OFF_G))[row * 4 + hd] = -expf(p.a_log[hd]) * sp;
    }
  }
}

DI void p0_transpose(const float* __restrict__ W, int ldw, bool is_win, u16* __restrict__ Wt, int kt, int nt, char* smem, int wv) {
  float* tile = (float*)smem;
  int tid_ = (wv << 6) | lane_id(); asm volatile("" : "+v"(tid_)); const int tid = tid_;
  const int c = tid & 63;
  const int n = nt * 64 + c;
  const int col = n + ((is_win && n >= 2048) ? 8 : 0);
#pragma unroll
  for (int i = 0; i < 16; ++i) {
    const int r = (tid >> 6) + 4 * i;
    tile[r * 65 + c] = __builtin_nontemporal_load(W + (size_t)(kt * 64 + r) * ldw + col);
  }
  __syncthreads();
  const int nn = tid >> 2, kp = (tid & 3) * 16;
  unsigned pk[8];
#pragma unroll
  for (int e = 0; e < 8; ++e) pk[e] = cvtpk(tile[(kp + 2 * e) * 65 + nn], tile[(kp + 2 * e + 1) * 65 + nn]);
  uint4* dst = (uint4*)(Wt + (size_t)(nt * 64 + nn) * 1024 + kt * 64 + kp);
  dst[0] = make_uint4(pk[0], pk[1], pk[2], pk[3]);
  dst[1] = make_uint4(pk[4], pk[5], pk[6], pk[7]);
  __syncthreads();
}

template <int EPI>
DI void gemm_tile(const Params& p, const u16* __restrict__ A, const u16* __restrict__ Bt, int m0, int n0, char* smem, int wv) {
  constexpr int K = 1024, NKT = K / 64;
  int tid_ = (wv << 6) | lane_id(); asm volatile("" : "+v"(tid_)); const int tid = tid_, wave = tid >> 6, lane = tid & 63, fr = lane & 15, fq = lane >> 4, wr = wave >> 1, wc = wave & 1;
  f32x4 acc[4][4];
#pragma unroll
  for (int i = 0; i < 4; ++i)
#pragma unroll
    for (int j = 0; j < 4; ++j) acc[i][j] = f32x4{0.f, 0.f, 0.f, 0.f};
  float4 xin[4][4];
  if (EPI == 2) {
#pragma unroll
    for (int mt = 0; mt < 4; ++mt)
#pragma unroll
      for (int nt = 0; nt < 4; ++nt)
        { const f32x4 t4 = __builtin_nontemporal_load((const f32x4*)(p.x + (size_t)(m0 + wr * 64 + mt * 16 + fr) * 1024 + n0 + wc * 64 + nt * 16 + 4 * fq));
          xin[mt][nt] = make_float4(t4[0], t4[1], t4[2], t4[3]); }
  }
  char* As = smem; char* Bs = smem + 32768;
  const int srow = tid >> 3, sc8 = (tid & 7) ^ ((tid >> 4) & 7);
  const u16* ag = A + (size_t)(m0 + srow) * K + sc8 * 8;
  const u16* bg = Bt + (size_t)(n0 + srow) * K + sc8 * 8;
#define G_GLDS(nb_, kt_) { _Pragma("unroll") for (int i = 0; i < 4; ++i) { \
    __builtin_amdgcn_global_load_lds((const unsigned*)(ag + (size_t)(32 * i) * K + (kt_) * 64), (unsigned*)(As + (nb_) + wv * 1024 + i * 4096), 16, 0, 0); \
    __builtin_amdgcn_global_load_lds((const unsigned*)(bg + (size_t)(32 * i) * K + (kt_) * 64), (unsigned*)(Bs + (nb_) + wv * 1024 + i * 4096), 16, 0, 0); } }
  G_GLDS(0, 0);
  __syncthreads();
  const int fsw = fr >> 1;
  for (int kt = 0; kt < NKT; ++kt) {
    const int buf = (kt & 1) * 16384;
    if (kt + 1 < NKT) G_GLDS(((kt + 1) & 1) * 16384, kt + 1);
#pragma unroll
    for (int ks = 0; ks < 2; ++ks) {
      bf16x8 af[4], bfr[4];
      const int sw = ((ks * 4 + fq) ^ fsw) << 4;
#pragma unroll
      for (int mt = 0; mt < 4; ++mt) af[mt] = *(const bf16x8*)(As + buf + (wr * 64 + mt * 16 + fr) * 128 + sw);
#pragma unroll
      for (int nt = 0; nt < 4; ++nt) bfr[nt] = *(const bf16x8*)(Bs + buf + (wc * 64 + nt * 16 + fr) * 128 + sw);
#pragma unroll
      for (int mt = 0; mt < 4; ++mt)
#pragma unroll
        for (int nt = 0; nt < 4; ++nt) acc[mt][nt] = MFMA16(bfr[nt], af[mt], acc[mt][nt]);
    }
    __syncthreads();
  }
  float qsc[4]; float4 qg4[4];
#pragma unroll
  for (int i = 0; i < 4; ++i) { qsc[i] = 1.f; qg4[i] = make_float4(1.f, 1.f, 1.f, 1.f); }
  if (EPI == 1 && n0 >= C_DFQ && n0 < C_DFV) {
    const bool isq = n0 < C_DFK;
    const float* gp = isq ? p.q_gain : p.k_gain;
#pragma unroll
    for (int nt = 0; nt < 4; ++nt) qg4[nt] = *(const float4*)(gp + nt * 16 + 4 * fq);
#pragma unroll
    for (int mt = 0; mt < 4; ++mt) {
      float ss = 0.f;
#pragma unroll
      for (int nt = 0; nt < 4; ++nt) ss += acc[mt][nt][0] * acc[mt][nt][0] + acc[mt][nt][1] * acc[mt][nt][1] + acc[mt][nt][2] * acc[mt][nt][2] + acc[mt][nt][3] * acc[mt][nt][3];
      ss += lx<16>(ss); ss = lx32_sum(ss);
      qsc[mt] = rsqrtf(ss * (1.f / 64.f) + EPSV) * (isq ? 0.125f * LOG2E : 1.f);
    }
  }
#pragma unroll
  for (int mt = 0; mt < 4; ++mt) {
    const int m = m0 + wr * 64 + mt * 16 + fr;
#pragma unroll
    for (int nt = 0; nt < 4; ++nt) {
      const int n = n0 + wc * 64 + nt * 16 + 4 * fq;
      if (EPI == 1) {
        u16* proj = (u16*)(p.ws + OFF_PROJ);
        uint2 pk; pk.x = cvtpk(acc[mt][nt][0] * qsc[mt] * qg4[nt].x, acc[mt][nt][1] * qsc[mt] * qg4[nt].y);
        pk.y = cvtpk(acc[mt][nt][2] * qsc[mt] * qg4[nt].z, acc[mt][nt][3] * qsc[mt] * qg4[nt].w);
        *(uint2*)(proj + (size_t)m * NP + n) = pk;
      } else {
        const float4 xi = xin[mt][nt];
        float4 o; o.x = xi.x + acc[mt][nt][0]; o.y = xi.y + acc[mt][nt][1]; o.z = xi.z + acc[mt][nt][2]; o.w = xi.w + acc[mt][nt][3];
        *(float4*)(p.out + (size_t)m * 1024 + n) = o;
      }
    }
  }
}

DI void p2_qknorm(const Params& p, int item, int wv) {
  int tid_ = (wv << 6) | lane_id(); asm volatile("" : "+v"(tid_)); const int tid = tid_, wave = tid >> 6, lane = tid & 63;
  const int row = item * 4 + wave;
  u16* pr = (u16*)(p.ws + OFF_PROJ) + (size_t)row * NP + C_DFQ + lane * 16;
  uint4 v0 = ((const uint4*)pr)[0], v1 = ((const uint4*)pr)[1];
  unsigned w[8] = {v0.x, v0.y, v0.z, v0.w, v1.x, v1.y, v1.z, v1.w};
  float f[16]; float ss = 0.f;
#pragma unroll
  for (int e = 0; e < 8; ++e) { f[2 * e] = bflo(w[e]); f[2 * e + 1] = bfhi(w[e]); ss += f[2 * e] * f[2 * e] + f[2 * e + 1] * f[2 * e + 1]; }
  ss += lx<1>(ss); ss += lx<2>(ss);
  const float rstd = rsqrtf(ss * (1.f / 64.f) + EPSV);
  const bool isq = lane < 32;
  const float* gp = (isq ? p.q_gain : p.k_gain) + (lane & 3) * 16;
  const float sc = rstd * (isq ? 0.125f * LOG2E : 1.f);
  unsigned o[8];
#pragma unroll
  for (int e = 0; e < 8; ++e) o[e] = cvtpk(f[2 * e] * sc * gp[2 * e], f[2 * e + 1] * sc * gp[2 * e + 1]);
  ((uint4*)pr)[0] = make_uint4(o[0], o[1], o[2], o[3]);
  ((uint4*)pr)[1] = make_uint4(o[4], o[5], o[6], o[7]);
}

DI void p2_prep(const Params& p, int item, char* smem, int wv) {
  int tid_ = (wv << 6) | lane_id(); asm volatile("" : "+v"(tid_)); const int tid = tid_, wave = tid >> 6, lane = tid & 63, fr = lane & 15, fq = lane >> 4;
  const int n = item & 31, h = (item >> 5) & 3, b = item >> 7;
  u16* qn = (u16*)smem;
  u16* kn = (u16*)(smem + 17408);
  u16* vb = (u16*)(smem + 34816);
  u16* Mb = (u16*)(smem + 51200);
  float* Md = (float*)(smem + 59392);
  u16* Dv = (u16*)(smem + 63488);
  u16* Asm = (u16*)(smem + 67584);
  float* gcs = (float*)(smem + 75776);
  float* bts = gcs + 64;
  float* egs = bts + 64;
  float* kds = egs + 64;
  const size_t tok0 = (size_t)b * SEQ + n * 64;
  const u16* proj = (const u16*)(p.ws + OFF_PROJ);
  unsigned char* dnb = p.ws + OFF_DN + (size_t)item * DN_CHUNK_B;

  if (wave == 0) {
    egs[lane] = ((const float*)(p.ws + OFF_G))[(tok0 + lane) * 4 + h];
    float gv = 0.f;
    for (int i = 0; i < 64; ++i) { const float t = egs[i]; gv += (i <= lane) ? t : 0.f; }
    gcs[lane] = gv;
    bts[lane] = ((const float*)(p.ws + OFF_BETA))[(tok0 + lane) * 4 + h];
    egs[lane] = __expf(gv);
    kds[lane] = __expf(__uint_as_float(__builtin_amdgcn_readlane(__float_as_uint(gv), 63)) - gv);
    if (lane == 63) ((float*)(p.ws + OFF_GLAST))[item] = gv;
  }
  {
    const int t0 = wave * 16;
    const u16* pcol = proj + h * 128 + 2 * lane;
    unsigned uq[19], uk[19], uv[19];
#pragma unroll
    for (int j = 0; j < 19; ++j) {
      const int tt = n * 64 + t0 - 3 + j;
      uq[j] = 0u; uk[j] = 0u; uv[j] = 0u;
      if (tt >= 0) {
        const u16* pp = pcol + ((size_t)b * SEQ + tt) * NP;
        uq[j] = __builtin_nontemporal_load((const unsigned*)(pp + C_DNQ)); uk[j] = __builtin_nontemporal_load((const unsigned*)(pp + C_DNK)); uv[j] = __builtin_nontemporal_load((const unsigned*)(pp + C_DNV));
      }
    }
    float2 cwq[4], cwk[4], cwv[4];
#pragma unroll
    for (int j = 0; j < 4; ++j) {
      cwq[j] = *(const float2*)(p.conv_w + j * 1536 + h * 128 + 2 * lane);
      cwk[j] = *(const float2*)(p.conv_w + j * 1536 + 512 + h * 128 + 2 * lane);
      cwv[j] = *(const float2*)(p.conv_w + j * 1536 + 1024 + h * 128 + 2 * lane);
    }
    asm volatile("" ::: "memory");
    float yqx[16], yqy[16], ykx[16], yky[16], sq[16], sk[16];
#pragma unroll
    for (int tt = 0; tt < 16; ++tt) {
      float ax = 0.f, ay = 0.f, bx = 0.f, by = 0.f, cx = 0.f, cy = 0.f;
#pragma unroll
      for (int j = 0; j < 4; ++j) {
        ax += cwq[j].x * bflo(uq[tt + j]); ay += cwq[j].y * bfhi(uq[tt + j]);
        bx += cwk[j].x * bflo(uk[tt + j]); by += cwk[j].y * bfhi(uk[tt + j]);
        cx += cwv[j].x * bflo(uv[tt + j]); cy += cwv[j].y * bfhi(uv[tt + j]);
      }
      ax = silu_f(ax); ay = silu_f(ay); bx = silu_f(bx); by = silu_f(by); cx = silu_f(cx); cy = silu_f(cy);
      yqx[tt] = ax; yqy[tt] = ay; ykx[tt] = bx; yky[tt] = by;
      sq[tt] = ax * ax + ay * ay; sk[tt] = bx * bx + by * by;
      *(unsigned*)(vb + (t0 + tt) * 128 + 2 * lane) = cvtpk(cx, cy);
    }
#define RED_STEP(X) { _Pragma("unroll") for (int tt = 0; tt < 16; ++tt) { sq[tt] += lx<X>(sq[tt]); sk[tt] += lx<X>(sk[tt]); } }
    RED_STEP(1) RED_STEP(2) RED_STEP(4) RED_STEP(8) RED_STEP(16)
#pragma unroll
    for (int tt = 0; tt < 16; ++tt) {
      const float rq = rsqrtf(lx32_sum(sq[tt]) + EPSV) * 0.08838834764831845f;
      const float rk = rsqrtf(lx32_sum(sk[tt]) + EPSV);
      *(unsigned*)(qn + (t0 + tt) * 136 + 2 * lane) = cvtpk(yqx[tt] * rq, yqy[tt] * rq);
      *(unsigned*)(kn + (t0 + tt) * 136 + 2 * lane) = cvtpk(ykx[tt] * rk, yky[tt] * rk);
    }
  }
  __syncthreads();
  {
    f32x4 akk[4], aqk[4];
#pragma unroll
    for (int i = 0; i < 4; ++i) { akk[i] = f32x4{0.f, 0.f, 0.f, 0.f}; aqk[i] = f32x4{0.f, 0.f, 0.f, 0.f}; }
#pragma unroll
    for (int ks = 0; ks < 4; ++ks) {
      const bf16x8 ak = *(const bf16x8*)((const char*)kn + (16 * wave + fr) * 272 + (32 * ks + 8 * fq) * 2);
      const bf16x8 aq = *(const bf16x8*)((const char*)qn + (16 * wave + fr) * 272 + (32 * ks + 8 * fq) * 2);
#pragma unroll
      for (int nt = 0; nt < 4; ++nt) {
        if (nt <= wave) {
          const bf16x8 bk = *(const bf16x8*)((const char*)kn + (16 * nt + fr) * 272 + (32 * ks + 8 * fq) * 2);
          akk[nt] = MFMA16(ak, bk, akk[nt]);
          aqk[nt] = MFMA16(aq, bk, aqk[nt]);
        }
      }
    }
#pragma unroll
    for (int nt = 0; nt < 4; ++nt)
#pragma unroll
      for (int j = 0; j < 4; ++j) {
        const int c = 16 * wave + 4 * fq + j, s = 16 * nt + fr;
        const float dec = (s <= c) ? __expf(gcs[c] - gcs[s]) : 0.f;
        const float mv = (s < c) ? bts[c] * akk[nt][j] * dec : 0.f;
        Mb[c * 64 + s] = f2bf(-mv);
        if (nt == wave) Md[wave * 256 + (c & 15) * 16 + (s & 15)] = mv;
        Asm[c * 64 + s] = f2bf((s <= c) ? aqk[nt][j] * dec : 0.f);
      }
    {
      const float* md = Md + wave * 256;
      float t[16];
#pragma unroll
      for (int i = 0; i < 16; ++i) t[i] = (i == lane) ? 1.f : 0.f;
#pragma unroll
      for (int j = 0; j < 15; ++j)
#pragma unroll
        for (int i = j + 1; i < 16; ++i) t[i] -= md[i * 16 + j] * t[j];
      if (lane < 16) {
#pragma unroll
        for (int i = 0; i < 16; ++i) Dv[wave * 256 + i * 16 + lane] = f2bf(t[i]);
      }
    }
  }
  __syncthreads();
  {
    const float glast = gcs[63];
#pragma unroll
    for (int it = 0; it < 4; ++it) {
      const int pp = tid + 256 * it;
      const int frag = pp >> 6, l2 = pp & 63, m = l2 & 15, qq = l2 >> 4;
      {
        const int mt = frag >> 2, ks = frag & 3, row = 16 * mt + m;
        const uint2 lo = *(const uint2*)((const char*)qn + row * 272 + (32 * ks + 4 * qq) * 2);
        const uint2 hi = *(const uint2*)((const char*)qn + row * 272 + (32 * ks + 16 + 4 * qq) * 2);
        const float e = egs[row];
        uint4 o;
        o.x = cvtpk(bflo(lo.x) * e, bfhi(lo.x) * e); o.y = cvtpk(bflo(lo.y) * e, bfhi(lo.y) * e);
        o.z = cvtpk(bflo(hi.x) * e, bfhi(hi.x) * e); o.w = cvtpk(bflo(hi.y) * e, bfhi(hi.y) * e);
        *(uint4*)(dnb + DN_QG + (size_t)pp * 16) = o;
      }
      {
        const int mtk = frag >> 1, ks = frag & 1, dk = 16 * mtk + m;
        float v[8];
#pragma unroll
        for (int j = 0; j < 8; ++j) {
          const int c = 32 * ks + ((j >> 2) << 4) + 4 * qq + (j & 3);
          v[j] = bf2f(kn[c * 136 + dk]) * kds[c];
        }
        uint4 o; o.x = cvtpk(v[0], v[1]); o.y = cvtpk(v[2], v[3]); o.z = cvtpk(v[4], v[5]); o.w = cvtpk(v[6], v[7]);
        *(uint4*)(dnb + DN_KD + (size_t)pp * 16) = o;
      }
      if (it < 2) {
        const int mt = frag >> 1, ks = frag & 1, row = 16 * mt + m;
        const uint2 lo = *(const uint2*)((const char*)Asm + row * 128 + (32 * ks + 4 * qq) * 2);
        const uint2 hi = *(const uint2*)((const char*)Asm + row * 128 + (32 * ks + 16 + 4 * qq) * 2);
        *(uint4*)(dnb + DN_A + (size_t)pp * 16) = make_uint4(lo.x, lo.y, hi.x, hi.y);
      }
    }
  }
  const bool isv = wave < 2;
  f32x4 Xs[4][4];
  {
    const f32x4 z4 = f32x4{0.f, 0.f, 0.f, 0.f};
    bf16x8 dinv[4], m10, m20, m30, m31;
#pragma unroll
    for (int I = 0; I < 4; ++I) {
      const uint2 lo = *(const uint2*)(Dv + I * 256 + fr * 16 + 4 * fq);
      dinv[I] = __builtin_bit_cast(bf16x8, make_uint4(lo.x, lo.y, 0u, 0u));
    }
#define MBFRAG(I_, P_) __builtin_bit_cast(bf16x8, make_uint4(((const uint2*)(Mb + (16 * (I_) + fr) * 64 + 32 * (P_) + 4 * fq))->x, ((const uint2*)(Mb + (16 * (I_) + fr) * 64 + 32 * (P_) + 4 * fq))->y, \
                                                              ((const uint2*)(Mb + (16 * (I_) + fr) * 64 + 32 * (P_) + 16 + 4 * fq))->x, ((const uint2*)(Mb + (16 * (I_) + fr) * 64 + 32 * (P_) + 16 + 4 * fq))->y))
    m10 = MBFRAG(1, 0); m20 = MBFRAG(2, 0); m30 = MBFRAG(3, 0); m31 = MBFRAG(3, 1);
#pragma unroll
    for (int nt = 0; nt < 4; ++nt) {
      const int colx = (64 * wave + 16 * nt + fr) & 127;
      const u16* srcp = isv ? (vb + colx) : (kn + colx);
      const int sst = isv ? 128 : 136;
      f32x4 R[4];
#pragma unroll
      for (int I = 0; I < 4; ++I)
#pragma unroll
        for (int j = 0; j < 4; ++j) {
          const int row = 16 * I + 4 * fq + j;
          R[I][j] = bf2f(srcp[row * sst]) * bts[row] * (isv ? 1.f : egs[row]);
        }
      const f32x4 X0 = MFMA16(dinv[0], pack8(R[0], z4), z4);
      const f32x4 Y1 = MFMA16(m10, pack8(X0, z4), R[1]);
      const f32x4 X1 = MFMA16(dinv[1], pack8(Y1, z4), z4);
      const bf16x8 x01 = pack8(X0, X1);
      const f32x4 Y2 = MFMA16(m20, x01, R[2]);
      const f32x4 X2 = MFMA16(dinv[2], pack8(Y2, z4), z4);
      f32x4 Y3 = MFMA16(m30, x01, R[3]);
      Y3 = MFMA16(m31, pack8(X2, z4), Y3);
      const f32x4 X3 = MFMA16(dinv[3], pack8(Y3, z4), z4);
      Xs[nt][0] = X0; Xs[nt][1] = X1; Xs[nt][2] = X2; Xs[nt][3] = X3;
    }
  }
  if (isv) {
#pragma unroll
    for (int nt = 0; nt < 4; ++nt)
#pragma unroll
      for (int I = 0; I < 4; ++I) {
        uint2 o; o.x = cvtpk(Xs[nt][I][0], Xs[nt][I][1]); o.y = cvtpk(Xs[nt][I][2], Xs[nt][I][3]);
        *(uint2*)(dnb + DN_U + (size_t)(((I * 8 + 4 * wave + nt) * 64 + lane) * 8)) = o;
      }
  }
  __syncthreads();
  if (!isv) {
#pragma unroll
    for (int nt = 0; nt < 4; ++nt) {
      const int colx = (64 * wave + 16 * nt + fr) & 127;
#pragma unroll
      for (int I = 0; I < 4; ++I)
#pragma unroll
        for (int j = 0; j < 4; ++j) qn[(16 * I + 4 * fq + j) * 136 + colx] = f2bf(-Xs[nt][I][j]);
    }
  }
  __syncthreads();
#pragma unroll
  for (int it = 0; it < 4; ++it) {
    const int pp = tid + 256 * it;
    const int frag = pp >> 6, l2 = pp & 63, m = l2 & 15, qq = l2 >> 4;
    const int mt = frag >> 2, ks = frag & 3, row = 16 * mt + m;
    const uint2 lo = *(const uint2*)((const char*)qn + row * 272 + (32 * ks + 4 * qq) * 2);
    const uint2 hi = *(const uint2*)((const char*)qn + row * 272 + (32 * ks + 16 + 4 * qq) * 2);
    *(uint4*)(dnb + DN_NEGW + (size_t)pp * 16) = make_uint4(lo.x, lo.y, hi.x, hi.y);
  }
  __syncthreads();
}

constexpr size_t OUT_SN = 0;
constexpr size_t OUT_VN = 33554432;
DI void p3_scan(const Params& p, int bh, char* smem, int wv) {
  int tid_ = (wv << 6) | lane_id(); asm volatile("" : "+v"(tid_)); const int tid = tid_, wave = tid >> 6, lane = tid & 63;
  f32x4 S[8][2]; bf16x8 Sb[4][2];
#pragma unroll
  for (int i = 0; i < 8; ++i) { S[i][0] = f32x4{0.f, 0.f, 0.f, 0.f}; S[i][1] = f32x4{0.f, 0.f, 0.f, 0.f}; }
#pragma unroll
  for (int i = 0; i < 4; ++i) { Sb[i][0] = bf16x8{0, 0, 0, 0, 0, 0, 0, 0}; Sb[i][1] = bf16x8{0, 0, 0, 0, 0, 0, 0, 0}; }
  char* L = smem;
  float* egl_s = (float*)(smem + 65536);
  const unsigned char* dn0 = p.ws + OFF_DN + (size_t)(bh * 32) * DN_CHUNK_B;
  unsigned char* sn0 = (unsigned char*)p.out + OUT_SN + (size_t)(bh * 32) * 32768;
  unsigned char* vn0 = (unsigned char*)p.out + OUT_VN + (size_t)(bh * 32) * 16384;
  if (tid < 32) egl_s[tid] = __expf(((const float*)(p.ws + OFF_GLAST))[bh * 32 + tid]);
  uint4 r0, r1, r2, r3, r4, r5, r6, r7; uint2 un[8];
#define SC_NT4(p_) __builtin_bit_cast(uint4, __builtin_nontemporal_load((const f32x4*)(p_)))
#define SC_LOADC(n_) { const uint4* a_ = (const uint4*)(dn0 + (size_t)(n_) * DN_CHUNK_B + DN_NEGW) + tid; \
                       const uint4* b_ = (const uint4*)(dn0 + (size_t)(n_) * DN_CHUNK_B + DN_KD) + tid; \
                       r0 = SC_NT4(a_); r1 = SC_NT4(a_ + 256); r2 = SC_NT4(a_ + 512); r3 = SC_NT4(a_ + 768); \
                       r4 = SC_NT4(b_); r5 = SC_NT4(b_ + 256); r6 = SC_NT4(b_ + 512); r7 = SC_NT4(b_ + 768); }
#define SC_LOADU(dst, n_) { const uint2* u_ = (const uint2*)(dn0 + (size_t)(n_) * DN_CHUNK_B + DN_U) + lane; \
                            dst[0] = u_[(0 + 2 * wave) * 64]; dst[1] = u_[(0 + 2 * wave + 1) * 64]; dst[2] = u_[(8 + 2 * wave) * 64]; dst[3] = u_[(8 + 2 * wave + 1) * 64]; \
                            dst[4] = u_[(16 + 2 * wave) * 64]; dst[5] = u_[(16 + 2 * wave + 1) * 64]; dst[6] = u_[(24 + 2 * wave) * 64]; dst[7] = u_[(24 + 2 * wave + 1) * 64]; }
#define SC_STOREL(buf) { uint4* l_ = (uint4*)(L + (buf) * 32768) + tid; \
                         l_[0] = r0; l_[256] = r1; l_[512] = r2; l_[768] = r3; l_[1024] = r4; l_[1280] = r5; l_[1536] = r6; l_[1792] = r7; }
  unsigned warm = 0u;
  const unsigned char* tbase = dn0 + (wv & 1) * 8192 + (wv >> 1) * 32768;
  const unsigned char* ubase = dn0 + DN_U + (wv & 1) * 8192;
#define SC_TOUCH(n_) { const unsigned toff_ = (unsigned)lane * 128u; \
    asm volatile("global_load_dword %0, %1, %2" : "+v"(warm) : "v"(toff_), "s"(tbase + (size_t)(n_) * DN_CHUNK_B) : "memory"); \
    asm volatile("global_load_dword %0, %1, %2" : "+v"(warm) : "v"(toff_), "s"(ubase + (size_t)(n_) * DN_CHUNK_B) : "memory"); }
  SC_TOUCH(2); SC_TOUCH(3); SC_TOUCH(4);
  SC_LOADC(0); SC_LOADU(un, 0); SC_STOREL(0);
  __syncthreads();
  SC_LOADC(1);
  for (int n = 0; n < 32; ++n) {
    const char* B = L + (n & 1) * 32768 + lane * 16;
    if (n + 5 < 32) SC_TOUCH(n + 5);
    f32x4 av[4][2];
#pragma unroll
    for (int mt = 0; mt < 4; ++mt)
#pragma unroll
      for (int nt = 0; nt < 2; ++nt) { const uint2 u2 = un[mt * 2 + nt]; av[mt][nt] = f32x4{bflo(u2.x), bfhi(u2.x), bflo(u2.y), bfhi(u2.y)}; }
    if (n + 1 < 32) SC_LOADU(un, n + 1);
#pragma unroll
    for (int mt = 0; mt < 4; ++mt)
#pragma unroll
      for (int ks = 0; ks < 4; ++ks) {
        const bf16x8 af = *(const bf16x8*)(B + (mt * 4 + ks) * 1024);
        av[mt][0] = MFMA16(af, Sb[ks][0], av[mt][0]);
        av[mt][1] = MFMA16(af, Sb[ks][1], av[mt][1]);
      }
    bf16x8 vbf[2][2];
#pragma unroll
    for (int k2 = 0; k2 < 2; ++k2)
#pragma unroll
      for (int nt = 0; nt < 2; ++nt) vbf[k2][nt] = pack8(av[2 * k2][nt], av[2 * k2 + 1][nt]);
    {
      unsigned char* sn = sn0 + (size_t)n * 32768 + lane * 16;
      unsigned char* vn = vn0 + (size_t)n * 16384 + lane * 16;
#pragma unroll
      for (int ks = 0; ks < 4; ++ks)
#pragma unroll
        for (int nt = 0; nt < 2; ++nt) *(bf16x8*)(sn + (ks * 8 + 2 * wave + nt) * 1024) = Sb[ks][nt];
#pragma unroll
      for (int k2 = 0; k2 < 2; ++k2)
#pragma unroll
        for (int nt = 0; nt < 2; ++nt) *(bf16x8*)(vn + (k2 * 8 + 2 * wave + nt) * 1024) = vbf[k2][nt];
    }
    const float egl = egl_s[n];
#pragma unroll
    for (int mk = 0; mk < 8; ++mk) {
#pragma unroll
      for (int nt = 0; nt < 2; ++nt) { S[mk][nt][0] *= egl; S[mk][nt][1] *= egl; S[mk][nt][2] *= egl; S[mk][nt][3] *= egl; }
#pragma unroll
      for (int k2 = 0; k2 < 2; ++k2) {
        const bf16x8 af = *(const bf16x8*)(B + 16384 + (mk * 2 + k2) * 1024);
        S[mk][0] = MFMA16(af, vbf[k2][0], S[mk][0]);
        S[mk][1] = MFMA16(af, vbf[k2][1], S[mk][1]);
      }
    }
#pragma unroll
    for (int ks = 0; ks < 4; ++ks)
#pragma unroll
      for (int nt = 0; nt < 2; ++nt) Sb[ks][nt] = pack8(S[2 * ks][nt], S[2 * ks + 1][nt]);
    if (n + 1 < 32) SC_STOREL((n + 1) & 1);
    if (n + 2 < 32) SC_LOADC(n + 2);
    __syncthreads();
  }
  asm volatile("s_waitcnt vmcnt(0)" ::: "memory");
  asm volatile("" :: "v"(warm));
  __syncthreads();
  if (tid == 0) {
    __builtin_amdgcn_fence(__ATOMIC_RELEASE, "agent");
    asm volatile("s_waitcnt vmcnt(0)" ::: "memory");
    __hip_atomic_store((unsigned*)(p.ws + OFF_CTR) + 128 + bh, 1u, __ATOMIC_RELAXED, __HIP_MEMORY_SCOPE_AGENT);
  }
}

DI void p4_dnout(const Params& p, int ci, char* smem, int wv) {
  int tid_ = (wv << 6) | lane_id(); asm volatile("" : "+v"(tid_)); const int tid = tid_, wave = tid >> 6, lane = tid & 63, fr = lane & 15, fq = lane >> 4;
  const int n = ci & 31, h = (ci >> 5) & 3, b = ci >> 7;
  float* rd = (float*)smem;
  const unsigned char* base = p.ws + OFF_DN + (size_t)ci * DN_CHUNK_B;
  const uint4* qg = (const uint4*)(base + DN_QG) + lane;
  const uint4* aa = (const uint4*)(base + DN_A) + lane;
  const unsigned char* sn = (const unsigned char*)p.out + OUT_SN + (size_t)ci * 32768 + lane * 16;
  const unsigned char* vn = (const unsigned char*)p.out + OUT_VN + (size_t)ci * 16384 + lane * 16;
  bf16x8 Sb[4][2], vbf[2][2];
#pragma unroll
  for (int ks = 0; ks < 4; ++ks)
#pragma unroll
    for (int nt = 0; nt < 2; ++nt) Sb[ks][nt] = *(const bf16x8*)(sn + (ks * 8 + 2 * wave + nt) * 1024);
#pragma unroll
  for (int k2 = 0; k2 < 2; ++k2)
#pragma unroll
    for (int nt = 0; nt < 2; ++nt) vbf[k2][nt] = *(const bf16x8*)(vn + (k2 * 8 + 2 * wave + nt) * 1024);
  f32x4 ao[4][2];
#pragma unroll
  for (int mt = 0; mt < 4; ++mt) {
    ao[mt][0] = f32x4{0.f, 0.f, 0.f, 0.f}; ao[mt][1] = f32x4{0.f, 0.f, 0.f, 0.f};
#pragma unroll
    for (int ks = 0; ks < 4; ++ks) {
      const bf16x8 af = __builtin_bit_cast(bf16x8, qg[(mt * 4 + ks) * 64]);
      ao[mt][0] = MFMA16(af, Sb[ks][0], ao[mt][0]);
      ao[mt][1] = MFMA16(af, Sb[ks][1], ao[mt][1]);
    }
#pragma unroll
    for (int k2 = 0; k2 < 2; ++k2) {
      const bf16x8 af = __builtin_bit_cast(bf16x8, aa[(mt * 2 + k2) * 64]);
      ao[mt][0] = MFMA16(af, vbf[k2][0], ao[mt][0]);
      ao[mt][1] = MFMA16(af, vbf[k2][1], ao[mt][1]);
    }
  }
  float gn[2];
  gn[0] = p.dn_out_gain[32 * wave + fr]; gn[1] = p.dn_out_gain[32 * wave + 16 + fr];
  const u16* proj = (const u16*)(p.ws + OFF_PROJ);
  u16* mixed = (u16*)(p.ws + OFF_HB);
#pragma unroll
  for (int mt = 0; mt < 4; ++mt)
#pragma unroll
    for (int j = 0; j < 4; ++j) {
      float s = ao[mt][0][j] * ao[mt][0][j] + ao[mt][1][j] * ao[mt][1][j];
      s += lx<1>(s); s += lx<2>(s); s += lx<4>(s); s += lx<8>(s);
      if (fr == 0) rd[wave * 64 + 16 * mt + 4 * fq + j] = s;
    }
  __syncthreads();
#pragma unroll
  for (int mt = 0; mt < 4; ++mt)
#pragma unroll
    for (int j = 0; j < 4; ++j) {
      const int c = 16 * mt + 4 * fq + j;
      const float tot = rd[c] + rd[64 + c] + rd[128 + c] + rd[192 + c];
      const float rstd = rsqrtf(tot * (1.f / 128.f) + EPSV);
      const size_t tok = (size_t)b * SEQ + n * 64 + c;
#pragma unroll
      for (int nt = 0; nt < 2; ++nt) {
        const int dv = 32 * wave + 16 * nt + fr;
        const float z = bf2f(proj[tok * NP + C_DNZ + h * 128 + dv]);
        mixed[tok * 1024 + h * 128 + dv] = f2bf(ao[mt][nt][j] * rstd * gn[nt] * silu_f(z));
      }
    }
  __syncthreads();
}

DI void p3_attn(const Params& p, int bh, int qb, char* smem, int wv) {
  int tid_ = (wv << 6) | lane_id(); asm volatile("" : "+v"(tid_)); const int tid = tid_, wave = tid >> 6, lane = tid & 63, fr = lane & 15, fq = lane >> 4;
  const int b = bh >> 2, h = bh & 3;
  char* Ks = smem; char* Vs = smem + 32768;
  const u16* proj = (const u16*)(p.ws + OFF_PROJ);
  const size_t tokb = (size_t)b * SEQ;
  const int qrow = qb * 64 + 16 * wave + fr;
  bf16x8 qf[2][2];
#pragma unroll
  for (int mp = 0; mp < 2; ++mp)
#pragma unroll
    for (int ks = 0; ks < 2; ++ks) qf[mp][ks] = __builtin_bit_cast(bf16x8, __builtin_nontemporal_load((const f32x4*)(proj + (tokb + qrow) * NP + C_DFQ + h * 128 + mp * 64 + 32 * ks + 8 * fq)));
  f32x4 O[2][8];
#pragma unroll
  for (int mp = 0; mp < 2; ++mp)
#pragma unroll
    for (int i = 0; i < 8; ++i) O[mp][i] = f32x4{0.f, 0.f, 0.f, 0.f};
  float mrun[2] = {-INFINITY, -INFINITY}, lrun[2] = {0.f, 0.f};
  const int ntiles = qb + 1;
  const int srow = tid >> 4, c16 = tid & 15;
  const int koff = srow * 256 + ((c16 ^ (srow & 15)) << 4);
  const int voff = srow * 256 + (((c16 >> 1) ^ (srow & 7)) << 5) + ((c16 & 1) << 4);
  const u16* kg = proj + (tokb + srow) * NP + C_DFK + h * 128 + c16 * 8;
  const u16* vg = proj + (tokb + srow) * NP + C_DFV + h * 128 + c16 * 8;
  uint4 rk[4], rv[4];
#pragma unroll
  for (int i = 0; i < 4; ++i) { rk[i] = *(const uint4*)(kg + (size_t)(16 * i) * NP); rv[i] = *(const uint4*)(vg + (size_t)(16 * i) * NP); }
#pragma unroll
  for (int i = 0; i < 4; ++i) { *(uint4*)(Ks + koff + i * 4096) = rk[i]; *(uint4*)(Vs + voff + i * 4096) = rv[i]; }
  __syncthreads();
  const int trr = fr >> 2, trp = fr & 3;
  for (int kt = 0; kt < ntiles; ++kt) {
    const int buf = (kt & 1) * 16384;
    if (kt + 1 < ntiles) {
#pragma unroll
      for (int i = 0; i < 4; ++i) {
        rk[i] = *(const uint4*)(kg + (size_t)((kt + 1) * 64 + 16 * i) * NP);
        rv[i] = *(const uint4*)(vg + (size_t)((kt + 1) * 64 + 16 * i) * NP);
      }
    }
    f32x4 st[2][4];
#pragma unroll
    for (int mp = 0; mp < 2; ++mp)
#pragma unroll
      for (int mt = 0; mt < 4; ++mt) {
        st[mp][mt] = f32x4{0.f, 0.f, 0.f, 0.f};
#pragma unroll
        for (int ks = 0; ks < 2; ++ks) {
          const bf16x8 ka = *(const bf16x8*)(Ks + buf + (16 * mt + fr) * 256 + (((mp * 8 + ks * 4 + fq) ^ fr) << 4));
          st[mp][mt] = MFMA16(ka, qf[mp][ks], st[mp][mt]);
        }
      }
    if (kt == qb) {
#pragma unroll
      for (int mt = 0; mt < 4; ++mt)
#pragma unroll
        for (int j = 0; j < 4; ++j) {
          const int key = kt * 64 + 16 * mt + 4 * fq + j;
          if (key > qrow) { st[0][mt][j] = -INFINITY; st[1][mt][j] = -INFINITY; }
        }
    }
    bf16x8 pf[2][2];
#pragma unroll
    for (int mp = 0; mp < 2; ++mp) {
      float mx = st[mp][0][0];
#pragma unroll
      for (int mt = 0; mt < 4; ++mt)
#pragma unroll
        for (int j = 0; j < 4; ++j) mx = fmaxf(mx, st[mp][mt][j]);
      mx = fmaxf(mx, lx<16>(mx)); mx = lx32_max(mx);
      if (__builtin_amdgcn_ballot_w64(mx > mrun[mp] + 8.f) != 0ull) {
        const float mnew = fmaxf(mrun[mp], mx);
        const float alpha = __builtin_amdgcn_exp2f(mrun[mp] - mnew);
        mrun[mp] = mnew;
        lrun[mp] *= alpha;
#pragma unroll
        for (int i = 0; i < 8; ++i) { O[mp][i][0] *= alpha; O[mp][i][1] *= alpha; O[mp][i][2] *= alpha; O[mp][i][3] *= alpha; }
      }
      const float mref = mrun[mp];
      float ps = 0.f;
#pragma unroll
      for (int mt = 0; mt < 4; ++mt)
#pragma unroll
        for (int j = 0; j < 4; ++j) { const float e = __builtin_amdgcn_exp2f(st[mp][mt][j] - mref); st[mp][mt][j] = e; ps += e; }
      lrun[mp] += ps;
      pf[mp][0] = pack8(st[mp][0], st[mp][1]);
      pf[mp][1] = pack8(st[mp][2], st[mp][3]);
    }
#pragma unroll
    for (int k2 = 0; k2 < 2; ++k2) {
      const int r0 = 32 * k2 + 4 * fq + trr, r1 = r0 + 16;
#pragma unroll
      for (int mv = 0; mv < 8; ++mv) {
        const s16x4 lo = vtr(Vs + buf + r0 * 256 + ((mv ^ (r0 & 7)) << 5) + 8 * trp);
        const s16x4 hi = vtr(Vs + buf + r1 * 256 + ((mv ^ (r1 & 7)) << 5) + 8 * trp);
        const bf16x8 va = __builtin_shufflevector(lo, hi, 0, 1, 2, 3, 4, 5, 6, 7);
        O[0][mv] = MFMA16(va, pf[0][k2], O[0][mv]);
        O[1][mv] = MFMA16(va, pf[1][k2], O[1][mv]);
      }
    }
    if (kt + 1 < ntiles) {
      const int nb = ((kt + 1) & 1) * 16384;
#pragma unroll
      for (int i = 0; i < 4; ++i) { *(uint4*)(Ks + nb + koff + i * 4096) = rk[i]; *(uint4*)(Vs + nb + voff + i * 4096) = rv[i]; }
    }
    __syncthreads();
  }
  int tid2 = (wv << 6) | lane_id(); asm volatile("" : "+v"(tid2));
  const int qrow_e = qb * 64 + 16 * (tid2 >> 6) + (tid2 & 15), fq_e = (tid2 >> 4) & 3;
  float inv[2];
#pragma unroll
  for (int mp = 0; mp < 2; ++mp) { float l = lrun[mp]; l += lx<16>(l); l = lx32_sum(l); inv[mp] = 1.f / l; }
  const float li = *(const float*)(smem + 73744) * inv[1];
  float ss = 0.f;
#pragma unroll
  for (int mv = 0; mv < 8; ++mv)
#pragma unroll
    for (int j = 0; j < 4; ++j) { const float o = O[0][mv][j] * inv[0] - li * O[1][mv][j]; O[0][mv][j] = o; ss += o * o; }
  ss += lx<16>(ss); ss = lx32_sum(ss);
  const float rstd = rsqrtf(ss * (1.f / 128.f) + EPSV) * 0.8f;
  u16* mixed = (u16*)(p.ws + OFF_HB);
#pragma unroll
  for (int mv = 0; mv < 8; ++mv) {
    const int dv = 16 * mv + 4 * fq_e;
    typedef unsigned u32x2 __attribute__((ext_vector_type(2)));
    const u32x2 zz_ = __builtin_nontemporal_load((const u32x2*)(proj + (tokb + qrow_e) * NP + C_DFZ + h * 128 + dv));
    const uint2 zz = make_uint2(zz_[0], zz_[1]);
    const float4 g4 = *(const float4*)(p.df_out_gain + dv);
    uint2 o;
    o.x = cvtpk(O[0][mv][0] * rstd * g4.x * silu_f(bflo(zz.x)), O[0][mv][1] * rstd * g4.y * silu_f(bfhi(zz.x)));
    o.y = cvtpk(O[0][mv][2] * rstd * g4.z * silu_f(bflo(zz.y)), O[0][mv][3] * rstd * g4.w * silu_f(bfhi(zz.y)));
    *(uint2*)(mixed + (tokb + qrow_e) * 1024 + 512 + h * 128 + dv) = o;
  }
}

#define XB_TMO      128
#define XB_XCNT(j)  (256  + 64 * (j))
#define XB_XSUB(j)  (1280 + 64 * (j))
#define XB_XGEN(j)  (2304 + 64 * (j))
#define XB_TOP      3328
#define XB_TOPGEN   3392
#define XCD_BAR_WORDS 3456
#define XB_SPIN_CAP (1u << 18)
#define LAS __attribute__((address_space(3)))
DI unsigned xb_ld(unsigned* p) { return __hip_atomic_load(p, __ATOMIC_RELAXED, __HIP_MEMORY_SCOPE_AGENT); }
DI unsigned xb_add(unsigned* p, unsigned v) { return __hip_atomic_fetch_add(p, v, __ATOMIC_RELAXED, __HIP_MEMORY_SCOPE_AGENT); }
DI unsigned xb_xcc_id() { return (unsigned)__builtin_amdgcn_s_getreg((3 << 11) | 20) & 0xFu; }
#define XB_SPIN(cond, bar) do { unsigned _sp = 0; while (cond) { __builtin_amdgcn_s_sleep(1); \
    if ((++_sp & 255u) == 0u) { if (xb_ld(&(bar)[XB_TMO])) break; if (_sp > XB_SPIN_CAP) { atomicAdd(&(bar)[XB_TMO], 1u); break; } } } } while (0)
DI void xcd_barrier_complete(unsigned* bar, unsigned x, unsigned& nloc, unsigned& nx) {
  const unsigned G = gridDim.x;
  unsigned sum, cnt, mine, sp = 0u;
  for (;;) {
    sum = 0u; cnt = 0u; mine = 0u;
#pragma unroll
    for (unsigned j = 0; j < 16; ++j) { const unsigned c = xb_ld(&bar[XB_XCNT(j)]); sum += c; cnt += (c > 0u) ? 1u : 0u; mine = (j == x) ? c : mine; }
    if (sum == G) break;
    __builtin_amdgcn_s_sleep(1);
    if ((++sp & 255u) == 0u) { if (xb_ld(&bar[XB_TMO])) break; if (sp > XB_SPIN_CAP) { atomicAdd(&bar[XB_TMO], 1u); break; } }
  }
  nloc = mine > 0u ? mine : 1u; nx = cnt > 0u ? cnt : 1u;
}
DI void xcd_barrier(unsigned* bar, volatile LAS unsigned* st, bool leader) {
  asm volatile("s_waitcnt vmcnt(0)" ::: "memory");
  __syncthreads();
  if (leader) {
    const unsigned x = xb_xcc_id();
    __builtin_amdgcn_s_waitcnt(0);
    unsigned nloc = st[0], nx = st[1];
    if (nloc == 0u) { xcd_barrier_complete(bar, x, nloc, nx); st[0] = nloc; st[1] = nx; }
    const unsigned old = xb_add(&bar[XB_XSUB(x)], 1u);
    const unsigned gen = old / nloc;
    if (old + 1u == (gen + 1u) * nloc) {
      __builtin_amdgcn_fence(__ATOMIC_RELEASE, "agent");
      asm volatile("s_waitcnt vmcnt(0)" ::: "memory");
      const unsigned og = xb_add(&bar[XB_TOP], 1u);
      const unsigned tg = og / nx;
      if (og + 1u == (tg + 1u) * nx) xb_add(&bar[XB_TOPGEN], 1u);
      else XB_SPIN(xb_ld(&bar[XB_TOPGEN]) == tg, bar);
      __builtin_amdgcn_fence(__ATOMIC_ACQUIRE, "agent");
      xb_add(&bar[XB_XGEN(x)], 1u);
      asm volatile("s_waitcnt vmcnt(0)" ::: "memory");
    } else {
      XB_SPIN(xb_ld(&bar[XB_XGEN(x)]) == gen, bar);
      __builtin_amdgcn_fence(__ATOMIC_ACQUIRE, "agent");
      asm volatile("s_waitcnt vmcnt(0)" ::: "memory");
    }
  }
  __syncthreads();
}

template <int ONLY>
__global__ void __launch_bounds__(256, 2) fwd_kernel(Params p) {
  __shared__ __attribute__((aligned(16))) char smem[SMEM_BYTES];
  const int nb = gridDim.x, bid = blockIdx.x;
  const int wv = __builtin_amdgcn_readfirstlane((int)(threadIdx.x >> 6));
  __shared__ uint4 xb_words;
  unsigned* const gbar = (unsigned*)(p.ws + OFF_BAR);
  volatile LAS unsigned* const xst = (volatile LAS unsigned*)&xb_words;
  if (ONLY < 0) {
    if (wv == 0 && lane_id() == 0) { xb_words = make_uint4(0u, 0u, 0u, 0u); (void)xb_add(&gbar[XB_XCNT(xb_xcc_id())], 1u); }
    __syncthreads();
    if (p.coop == 2) cg::this_grid().sync();
  }
#define GRID_SYNC() xcd_barrier(gbar, xst, wv == 0 && lane_id() == 0)
  if (ONLY < 0 || ONLY == 0) {
    if (bid == 0 && wv < 3) ((unsigned*)(p.ws + OFF_CTR))[(wv << 6) | lane_id()] = 0u;
    for (int it = bid; it < 1024 + 256; it += nb) {
      if (it < 1024) p0_transpose(p.w_in, WIN_LD, true, (u16*)(p.ws + OFF_WTIN), it & 15, it >> 4, smem, wv);
      else { const int t = it - 1024; p0_transpose(p.w_out, 1024, false, (u16*)(p.ws + OFF_WTOUT), t & 15, t >> 4, smem, wv); }
    }
    p0_fill_w8(p, smem, wv);
    __syncthreads();
    for (int it = bid; it < 4096; it += nb) p0_rows(p, it, smem, wv);
    __syncthreads();
  }
  if (ONLY < 0) GRID_SYNC();
  if (ONLY < 0 || ONLY == 1) {
    for (int rep = 0; rep < REP_G1; ++rep)
    for (int it = bid; it < 4096; it += nb)
      gemm_tile<1>(p, (const u16*)(p.ws + OFF_HB), (const u16*)(p.ws + OFF_WTIN), (it >> 5) * 128, (it & 31) * 128, smem, wv);
  }
  if (ONLY < 0) GRID_SYNC();
  if (ONLY < 0 || ONLY == 2) {
    for (int l = bid >> 3; l < 128; l += (nb >> 3)) p2_prep(p, (bid & 7) * 128 + l, smem, wv);
#if REP_PREP > 1
    for (int it = bid; it < 1024; it += nb) p2_prep(p, it, smem, wv);
#endif
  }
  if (ONLY < 0) GRID_SYNC();
  if (ONLY < 0 || ONLY == 3) {
    const int lane = lane_id();
    const float s1 = wave_sum(p.lq1[lane] * p.lk1[lane]), s2 = wave_sum(p.lq2[lane] * p.lk2[lane]);
    if (wv == 0 && lane == 0) *(float*)(smem + 73744) = __expf(s1) - __expf(s2) + 0.2f;
    __syncthreads();
    if (bid < 32) p3_scan(p, (bid & 7) * 4 + (bid >> 3), smem, wv);
    int* slot = (int*)(smem + 73728);
    const int xcc = bid & 7;
    for (int qi = 0; qi < 8; ++qi) {
      const int qx = (xcc + qi) & 7;
      unsigned* ctr = (unsigned*)(p.ws + OFF_CTR) + qx * 16;
      while (true) {
        if (wv == 0 && lane == 0) *slot = (int)atomicAdd(ctr, 1u);
        __syncthreads();
        const int it = *slot;
        __syncthreads();
        if (it >= 256) break;
        if (it < 128) {
          p3_attn(p, qx * 4 + (it & 3), 31 - (it >> 2), smem, wv);
        } else {
          const int bh = qx * 4 + (it & 3);
          if (wv == 0 && lane == 0) {
            unsigned* fl = (unsigned*)(p.ws + OFF_CTR) + 128 + bh;
            while (__hip_atomic_load(fl, __ATOMIC_RELAXED, __HIP_MEMORY_SCOPE_AGENT) == 0u) __builtin_amdgcn_s_sleep(2);
            __builtin_amdgcn_fence(__ATOMIC_ACQUIRE, "agent");
            asm volatile("s_waitcnt vmcnt(0)" ::: "memory");
          }
          __syncthreads();
          p4_dnout(p, bh * 32 + ((it - 128) >> 2), smem, wv);
        }
      }
    }
  }
  if (ONLY < 0) GRID_SYNC();
  if (ONLY < 0 || ONLY == 5) {
    for (int it = bid; it < 1024; it += nb) {
      const int xq = it & 7, s = it >> 3;
      gemm_tile<2>(p, (const u16*)(p.ws + OFF_HB), (const u16*)(p.ws + OFF_WTOUT), (xq * 16 + (s >> 3)) * 128, (s & 7) * 128, smem, wv);
    }
  }
}

extern "C" void kernel_launch(void* const* d_in, const int* in_sizes, int n_in, void* d_out, int out_size, void* d_ws, size_t ws_size,
                              hipStream_t stream) {
  Params p{};
  p.x = (const float*)d_in[0]; p.norm_gain = (const float*)d_in[1]; p.w_in = (const float*)d_in[2]; p.conv_w = (const float*)d_in[3];
  p.a_log = (const float*)d_in[4]; p.dt_bias = (const float*)d_in[5]; p.dn_out_gain = (const float*)d_in[6]; p.q_gain = (const float*)d_in[7];
  p.k_gain = (const float*)d_in[8]; p.lq1 = (const float*)d_in[9]; p.lk1 = (const float*)d_in[10]; p.lq2 = (const float*)d_in[11];
  p.lk2 = (const float*)d_in[12]; p.df_out_gain = (const float*)d_in[13]; p.w_out = (const float*)d_in[14];
  p.out = (float*)d_out; p.ws = (unsigned char*)d_ws;
  static int grid_blocks = 0;
  if (!grid_blocks) {
    int dev = 0, cus = 0, per_cu = 0;
    (void)hipGetDevice(&dev);
    (void)hipDeviceGetAttribute(&cus, hipDeviceAttributeMultiprocessorCount, dev);
#if USE_COOP
    (void)hipOccupancyMaxActiveBlocksPerMultiprocessor(&per_cu, fwd_kernel<-1>, 256, 0);
#else
    per_cu = 2;
#endif
    if (per_cu > 2) per_cu = 2;
    if (per_cu < 1) per_cu = 1;
    grid_blocks = cus * per_cu;
  }
#if USE_COOP
  (void)hipMemsetAsync((unsigned char*)d_ws + OFF_BAR, 0, 3456 * 4, stream);
  p.phase_lo = 0; p.phase_hi = 5; p.coop = 1;
  void* args[] = {&p};
  hipError_t e = hipLaunchCooperativeKernel((void*)fwd_kernel<-1>, dim3(grid_blocks), dim3(256), args, 0, stream);
  if (e != hipSuccess) fprintf(stderr, "cooperative launch failed: %s (grid %d)\n", hipGetErrorString(e), grid_blocks);
#else
  p.coop = 0;
  p.phase_lo = 0; p.phase_hi = 1; hipLaunchKernelGGL(fwd_kernel<0>, dim3(grid_blocks), dim3(256), 0, stream, p);
  p.phase_lo = 1; p.phase_hi = 2; hipLaunchKernelGGL(fwd_kernel<1>, dim3(grid_blocks), dim3(256), 0, stream, p);
  p.phase_lo = 2; p.phase_hi = 3; hipLaunchKernelGGL(fwd_kernel<2>, dim3(grid_blocks), dim3(256), 0, stream, p);
  p.phase_lo = 3; p.phase_hi = 4; hipLaunchKernelGGL(fwd_kernel<3>, dim3(grid_blocks), dim3(256), 0, stream, p);
  p.phase_lo = 4; p.phase_hi = 5; hipLaunchKernelGGL(fwd_kernel<4>, dim3(grid_blocks), dim3(256), 0, stream, p);
  p.phase_lo = 5; p.phase_hi = 6; hipLaunchKernelGGL(fwd_kernel<5>, dim3(grid_blocks), dim3(256), 0, stream, p);
#endif
}
```

```cpp
#include <hip/hip_runtime.h>
#include <hip/hip_cooperative_groups.h>
#include <cstdio>
#include <cstdint>
namespace cg = cooperative_groups;

#ifndef REP_P0
#define REP_P0 1
#endif
#ifndef REP_DNOUT
#define REP_DNOUT 1
#endif
#ifndef REP_G1
#define REP_G1 1
#endif
#ifndef REP_PREP
#define REP_PREP 1
#endif
#ifndef REP_SCAN
#define REP_SCAN 1
#endif
#ifndef REP_ATTN
#define REP_ATTN 1
#endif
#ifndef USE_COOP
#define USE_COOP 1
#endif

#define DI __device__ __forceinline__
typedef __attribute__((ext_vector_type(8))) short bf16x8;
typedef __attribute__((ext_vector_type(4))) short s16x4;
typedef __attribute__((ext_vector_type(4))) float f32x4;
typedef short v4i16_t __attribute__((ext_vector_type(4)));
typedef __attribute__((address_space(3))) const char* lds_cptr;
typedef unsigned short u16;

constexpr int SEQ = 2048, NTOK = 16384, DMODEL = 1024, NP = 4096, WIN_LD = 4104;
constexpr int C_DNQ = 0, C_DNK = 512, C_DNV = 1024, C_DNZ = 1536, C_DFQ = 2048, C_DFK = 2560, C_DFV = 3072, C_DFZ = 3584;
constexpr float EPSV = 1e-6f;
constexpr float LOG2E = 1.4426950408889634f;

constexpr size_t OFF_PROJ = 0;
constexpr size_t OFF_HB = 134217728;
constexpr size_t OFF_WTIN = OFF_HB + 33554432;
constexpr size_t OFF_WTOUT = OFF_WTIN + 8388608;
constexpr size_t OFF_G = OFF_WTOUT + 2097152;
constexpr size_t OFF_BETA = OFF_G + 262144;
constexpr size_t OFF_DN = OFF_BETA + 262144;
constexpr size_t DN_CHUNK_B = 73728;
constexpr size_t DN_NEGW = 0, DN_QG = 16384, DN_KD = 32768, DN_A = 49152, DN_U = 57344;
constexpr size_t OFF_GLAST = OFF_DN + DN_CHUNK_B * 1024;
constexpr size_t OFF_CTR = OFF_GLAST + 4096;
constexpr size_t OFF_BAR = OFF_CTR + 1024;

constexpr int SMEM_BYTES = 77824;

struct Params {
  const float *x, *norm_gain, *w_in, *conv_w, *a_log, *dt_bias, *dn_out_gain, *q_gain, *k_gain;
  const float *lq1, *lk1, *lq2, *lk2, *df_out_gain, *w_out;
  float* out;
  unsigned char* ws;
  int phase_lo, phase_hi, coop, pad0;
};

typedef __bf16 bf16x2_t __attribute__((ext_vector_type(2)));
DI unsigned cvtpk(float lo, float hi) { bf16x2_t v; v[0] = (__bf16)lo; v[1] = (__bf16)hi; return __builtin_bit_cast(unsigned, v); }
DI float bf2f(u16 h) { return __uint_as_float(((unsigned)h) << 16); }
DI float bflo(unsigned u) { return __uint_as_float(u << 16); }
DI float bfhi(unsigned u) { return __uint_as_float(u & 0xffff0000u); }
DI u16 f2bf(float x) { return (u16)(cvtpk(x, 0.f) & 0xffffu); }
template <int X> DI float lx(float v) { return __builtin_bit_cast(float, __builtin_amdgcn_ds_swizzle(__builtin_bit_cast(int, v), 0x1f | (X << 10))); }
DI float lx32_sum(float v) { auto rr = __builtin_amdgcn_permlane32_swap(__float_as_uint(v), __float_as_uint(v), false, false); return __uint_as_float(rr[0]) + __uint_as_float(rr[1]); }
DI float lx32_max(float v) { auto rr = __builtin_amdgcn_permlane32_swap(__float_as_uint(v), __float_as_uint(v), false, false); return fmaxf(__uint_as_float(rr[0]), __uint_as_float(rr[1])); }
DI float wave_sum(float v) {
  v += lx<1>(v); v += lx<2>(v); v += lx<4>(v); v += lx<8>(v); v += lx<16>(v);
  return lx32_sum(v);
}
DI int lane_id() { int l; asm volatile("v_mbcnt_lo_u32_b32 %0, -1, 0\n\tv_mbcnt_hi_u32_b32 %0, -1, %0" : "=v"(l)); return l; }
DI float silu_f(float y) { return y * __builtin_amdgcn_rcpf(1.f + __expf(-y)); }
DI s16x4 vtr(const char* p) { return __builtin_bit_cast(s16x4, __builtin_amdgcn_ds_read_tr16_b64_v4i16((__attribute__((address_space(3))) v4i16_t*)(lds_cptr)p)); }
#define MFMA16(a, b, c) __builtin_amdgcn_mfma_f32_16x16x32_bf16((a), (b), (c), 0, 0, 0)
DI bf16x8 pack8(const f32x4& a, const f32x4& b) {
  uint4 u; u.x = cvtpk(a[0], a[1]); u.y = cvtpk(a[2], a[3]); u.z = cvtpk(b[0], b[1]); u.w = cvtpk(b[2], b[3]);
  return __builtin_bit_cast(bf16x8, u);
}

DI void p0_fill_w8(const Params& p, char* smem, int wv) {
  int tid_ = (wv << 6) | lane_id(); asm volatile("" : "+v"(tid_)); const int tid = tid_;
  float4* pl = (float4*)smem;
#pragma unroll
  for (int j = 0; j < 8; ++j) {
    const int q = tid + 256 * j, k = q >> 1, c4 = q & 1;
    pl[(c4 * 4 + (k & 3)) * 256 + (k >> 2)] = *(const float4*)(p.w_in + (size_t)k * WIN_LD + 2048 + 4 * c4);
  }
}
DI void p0_rows(const Params& p, int item, char* smem, int wv) {
  int tid_ = (wv << 6) | lane_id(); asm volatile("" : "+v"(tid_)); const int tid = tid_, wave = tid >> 6, lane = tid & 63;
  const int row = item * 4 + wave;
  const float4* pl = (const float4*)smem;
  const float4* xr = (const float4*)(p.x + (size_t)row * 1024);
  float4 xv[4]; float ss = 0.f;
  float acc[8];
#pragma unroll
  for (int j = 0; j < 8; ++j) acc[j] = 0.f;
#pragma unroll
  for (int i = 0; i < 4; ++i) {
    { const f32x4 t4 = __builtin_nontemporal_load((const f32x4*)xr + lane + 64 * i); xv[i] = make_float4(t4[0], t4[1], t4[2], t4[3]); }
    const float4 g = ((const float4*)p.norm_gain)[lane + 64 * i];
    ss += xv[i].x * xv[i].x + xv[i].y * xv[i].y + xv[i].z * xv[i].z + xv[i].w * xv[i].w;
    xv[i].x *= g.x; xv[i].y *= g.y; xv[i].z *= g.z; xv[i].w *= g.w;
    const float hh[4] = {xv[i].x, xv[i].y, xv[i].z, xv[i].w};
#pragma unroll
    for (int e = 0; e < 4; ++e) {
      const float4 w0 = pl[(0 + e) * 256 + lane + 64 * i], w1 = pl[(4 + e) * 256 + lane + 64 * i];
      acc[0] += hh[e] * w0.x; acc[1] += hh[e] * w0.y; acc[2] += hh[e] * w0.z; acc[3] += hh[e] * w0.w;
      acc[4] += hh[e] * w1.x; acc[5] += hh[e] * w1.y; acc[6] += hh[e] * w1.z; acc[7] += hh[e] * w1.w;
    }
  }
  ss = wave_sum(ss);
#pragma unroll
  for (int j = 0; j < 8; ++j) acc[j] = wave_sum(acc[j]);
  const float rstd = rsqrtf(ss * (1.f / 1024.f) + EPSV);
  u16* hb = (u16*)(p.ws + OFF_HB);
#pragma unroll
  for (int i = 0; i < 4; ++i) {
    uint2 pk; pk.x = cvtpk(xv[i].x * rstd, xv[i].y * rstd); pk.y = cvtpk(xv[i].z * rstd, xv[i].w * rstd);
    *(uint2*)(hb + (size_t)row * 1024 + (lane + 64 * i) * 4) = pk;
  }
  if (lane < 8) {
    float v = acc[0];
    v = lane == 1 ? acc[1] : v; v = lane == 2 ? acc[2] : v; v = lane == 3 ? acc[3] : v;
    v = lane == 4 ? acc[4] : v; v = lane == 5 ? acc[5] : v; v = lane == 6 ? acc[6] : v; v = lane == 7 ? acc[7] : v;
    v *= rstd;
    const int hd = lane & 3;
    if (lane < 4) {
      ((float*)(p.ws + OFF_BETA))[row * 4 + hd] = 1.f / (1.f + expf(-v));
    } else {
      const float a = v + p.dt_bias[hd];
      const float sp = fmaxf(a, 0.f) + log1pf(expf(-fabsf(a)));
      ((float*)(p.ws + OFF_G))[row * 4 + hd] = -expf(p.a_log[hd]) * sp;
    }
  }
}

DI void p0_transpose(const float* __restrict__ W, int ldw, bool is_win, u16* __restrict__ Wt, int kt, int nt, char* smem, int wv) {
  float* tile = (float*)smem;
  int tid_ = (wv << 6) | lane_id(); asm volatile("" : "+v"(tid_)); const int tid = tid_;
  const int c = tid & 63;
  const int n = nt * 64 + c;
  const int col = n + ((is_win && n >= 2048) ? 8 : 0);
#pragma unroll
  for (int i = 0; i < 16; ++i) {
    const int r = (tid >> 6) + 4 * i;
    tile[r * 65 + c] = __builtin_nontemporal_load(W + (size_t)(kt * 64 + r) * ldw + col);
  }
  __syncthreads();
  const int nn = tid >> 2, kp = (tid & 3) * 16;
  unsigned pk[8];
#pragma unroll
  for (int e = 0; e < 8; ++e) pk[e] = cvtpk(tile[(kp + 2 * e) * 65 + nn], tile[(kp + 2 * e + 1) * 65 + nn]);
  uint4* dst = (uint4*)(Wt + (size_t)(nt * 64 + nn) * 1024 + kt * 64 + kp);
  dst[0] = make_uint4(pk[0], pk[1], pk[2], pk[3]);
  dst[1] = make_uint4(pk[4], pk[5], pk[6], pk[7]);
  __syncthreads();
}

template <int EPI>
DI void gemm_tile(const Params& p, const u16* __restrict__ A, const u16* __restrict__ Bt, int m0, int n0, char* smem, int wv) {
  constexpr int K = 1024, NKT = K / 64;
  int tid_ = (wv << 6) | lane_id(); asm volatile("" : "+v"(tid_)); const int tid = tid_, wave = tid >> 6, lane = tid & 63, fr = lane & 15, fq = lane >> 4, wr = wave >> 1, wc = wave & 1;
  f32x4 acc[4][4];
#pragma unroll
  for (int i = 0; i < 4; ++i)
#pragma unroll
    for (int j = 0; j < 4; ++j) acc[i][j] = f32x4{0.f, 0.f, 0.f, 0.f};
  float4 xin[4][4];
  if (EPI == 2) {
#pragma unroll
    for (int mt = 0; mt < 4; ++mt)
#pragma unroll
      for (int nt = 0; nt < 4; ++nt)
        { const f32x4 t4 = __builtin_nontemporal_load((const f32x4*)(p.x + (size_t)(m0 + wr * 64 + mt * 16 + fr) * 1024 + n0 + wc * 64 + nt * 16 + 4 * fq));
          xin[mt][nt] = make_float4(t4[0], t4[1], t4[2], t4[3]); }
  }
  char* As = smem; char* Bs = smem + 32768;
  const int srow = tid >> 3, sc8 = (tid & 7) ^ ((tid >> 4) & 7);
  const u16* ag = A + (size_t)(m0 + srow) * K + sc8 * 8;
  const u16* bg = Bt + (size_t)(n0 + srow) * K + sc8 * 8;
#define G_GLDS(nb_, kt_) { _Pragma("unroll") for (int i = 0; i < 4; ++i) { \
    __builtin_amdgcn_global_load_lds((const unsigned*)(ag + (size_t)(32 * i) * K + (kt_) * 64), (unsigned*)(As + (nb_) + wv * 1024 + i * 4096), 16, 0, 0); \
    __builtin_amdgcn_global_load_lds((const unsigned*)(bg + (size_t)(32 * i) * K + (kt_) * 64), (unsigned*)(Bs + (nb_) + wv * 1024 + i * 4096), 16, 0, 0); } }
  G_GLDS(0, 0);
  __syncthreads();
  const int fsw = fr >> 1;
  for (int kt = 0; kt < NKT; ++kt) {
    const int buf = (kt & 1) * 16384;
    if (kt + 1 < NKT) G_GLDS(((kt + 1) & 1) * 16384, kt + 1);
#pragma unroll
    for (int ks = 0; ks < 2; ++ks) {
      bf16x8 af[4], bfr[4];
      const int sw = ((ks * 4 + fq) ^ fsw) << 4;
#pragma unroll
      for (int mt = 0; mt < 4; ++mt) af[mt] = *(const bf16x8*)(As + buf + (wr * 64 + mt * 16 + fr) * 128 + sw);
#pragma unroll
      for (int nt = 0; nt < 4; ++nt) bfr[nt] = *(const bf16x8*)(Bs + buf + (wc * 64 + nt * 16 + fr) * 128 + sw);
#pragma unroll
      for (int mt = 0; mt < 4; ++mt)
#pragma unroll
        for (int nt = 0; nt < 4; ++nt) acc[mt][nt] = MFMA16(bfr[nt], af[mt], acc[mt][nt]);
    }
    __syncthreads();
  }
  float qsc[4]; float4 qg4[4];
#pragma unroll
  for (int i = 0; i < 4; ++i) { qsc[i] = 1.f; qg4[i] = make_float4(1.f, 1.f, 1.f, 1.f); }
  if (EPI == 1 && n0 >= C_DFQ && n0 < C_DFV) {
    const bool isq = n0 < C_DFK;
    const float* gp = isq ? p.q_gain : p.k_gain;
#pragma unroll
    for (int nt = 0; nt < 4; ++nt) qg4[nt] = *(const float4*)(gp + nt * 16 + 4 * fq);
#pragma unroll
    for (int mt = 0; mt < 4; ++mt) {
      float ss = 0.f;
#pragma unroll
      for (int nt = 0; nt < 4; ++nt) ss += acc[mt][nt][0] * acc[mt][nt][0] + acc[mt][nt][1] * acc[mt][nt][1] + acc[mt][nt][2] * acc[mt][nt][2] + acc[mt][nt][3] * acc[mt][nt][3];
      ss += lx<16>(ss); ss = lx32_sum(ss);
      qsc[mt] = rsqrtf(ss * (1.f / 64.f) + EPSV) * (isq ? 0.125f * LOG2E : 1.f);
    }
  }
#pragma unroll
  for (int mt = 0; mt < 4; ++mt) {
    const int m = m0 + wr * 64 + mt * 16 + fr;
#pragma unroll
    for (int nt = 0; nt < 4; ++nt) {
      const int n = n0 + wc * 64 + nt * 16 + 4 * fq;
      if (EPI == 1) {
        u16* proj = (u16*)(p.ws + OFF_PROJ);
        uint2 pk; pk.x = cvtpk(acc[mt][nt][0] * qsc[mt] * qg4[nt].x, acc[mt][nt][1] * qsc[mt] * qg4[nt].y);
        pk.y = cvtpk(acc[mt][nt][2] * qsc[mt] * qg4[nt].z, acc[mt][nt][3] * qsc[mt] * qg4[nt].w);
        *(uint2*)(proj + (size_t)m * NP + n) = pk;
      } else {
        const float4 xi = xin[mt][nt];
        float4 o; o.x = xi.x + acc[mt][nt][0]; o.y = xi.y + acc[mt][nt][1]; o.z = xi.z + acc[mt][nt][2]; o.w = xi.w + acc[mt][nt][3];
        *(float4*)(p.out + (size_t)m * 1024 + n) = o;
      }
    }
  }
}

DI void p2_qknorm(const Params& p, int item, int wv) {
  int tid_ = (wv << 6) | lane_id(); asm volatile("" : "+v"(tid_)); const int tid = tid_, wave = tid >> 6, lane = tid & 63;
  const int row = item * 4 + wave;
  u16* pr = (u16*)(p.ws + OFF_PROJ) + (size_t)row * NP + C_DFQ + lane * 16;
  uint4 v0 = ((const uint4*)pr)[0], v1 = ((const uint4*)pr)[1];
  unsigned w[8] = {v0.x, v0.y, v0.z, v0.w, v1.x, v1.y, v1.z, v1.w};
  float f[16]; float ss = 0.f;
#pragma unroll
  for (int e = 0; e < 8; ++e) { f[2 * e] = bflo(w[e]); f[2 * e + 1] = bfhi(w[e]); ss += f[2 * e] * f[2 * e] + f[2 * e + 1] * f[2 * e + 1]; }
  ss += lx<1>(ss); ss += lx<2>(ss);
  const float rstd = rsqrtf(ss * (1.f / 64.f) + EPSV);
  const bool isq = lane < 32;
  const float* gp = (isq ? p.q_gain : p.k_gain) + (lane & 3) * 16;
  const float sc = rstd * (isq ? 0.125f * LOG2E : 1.f);
  unsigned o[8];
#pragma unroll
  for (int e = 0; e < 8; ++e) o[e] = cvtpk(f[2 * e] * sc * gp[2 * e], f[2 * e + 1] * sc * gp[2 * e + 1]);
  ((uint4*)pr)[0] = make_uint4(o[0], o[1], o[2], o[3]);
  ((uint4*)pr)[1] = make_uint4(o[4], o[5], o[6], o[7]);
}

DI void p2_prep(const Params& p, int item, char* smem, int wv) {
  int tid_ = (wv << 6) | lane_id(); asm volatile("" : "+v"(tid_)); const int tid = tid_, wave = tid >> 6, lane = tid & 63, fr = lane & 15, fq = lane >> 4;
  const int n = item & 31, h = (item >> 5) & 3, b = item >> 7;
  u16* qn = (u16*)smem;
  u16* kn = (u16*)(smem + 17408);
  u16* vb = (u16*)(smem + 34816);
  u16* Mb = (u16*)(smem + 51200);
  float* Md = (float*)(smem + 59392);
  u16* Dv = (u16*)(smem + 63488);
  u16* Asm = (u16*)(smem + 67584);
  float* gcs = (float*)(smem + 75776);
  float* bts = gcs + 64;
  float* egs = bts + 64;
  float* kds = egs + 64;
  const size_t tok0 = (size_t)b * SEQ + n * 64;
  const u16* proj = (const u16*)(p.ws + OFF_PROJ);
  unsigned char* dnb = p.ws + OFF_DN + (size_t)item * DN_CHUNK_B;

  if (wave == 0) {
    egs[lane] = ((const float*)(p.ws + OFF_G))[(tok0 + lane) * 4 + h];
    float gv = 0.f;
    for (int i = 0; i < 64; ++i) { const float t = egs[i]; gv += (i <= lane) ? t : 0.f; }
    gcs[lane] = gv;
    bts[lane] = ((const float*)(p.ws + OFF_BETA))[(tok0 + lane) * 4 + h];
    egs[lane] = __expf(gv);
    kds[lane] = __expf(__uint_as_float(__builtin_amdgcn_readlane(__float_as_uint(gv), 63)) - gv);
    if (lane == 63) ((float*)(p.ws + OFF_GLAST))[item] = gv;
  }
  {
    const int t0 = wave * 16;
    const u16* pcol = proj + h * 128 + 2 * lane;
    unsigned uq[19], uk[19], uv[19];
#pragma unroll
    for (int j = 0; j < 19; ++j) {
      const int tt = n * 64 + t0 - 3 + j;
      uq[j] = 0u; uk[j] = 0u; uv[j] = 0u;
      if (tt >= 0) {
        const u16* pp = pcol + ((size_t)b * SEQ + tt) * NP;
        uq[j] = __builtin_nontemporal_load((const unsigned*)(pp + C_DNQ)); uk[j] = __builtin_nontemporal_load((const unsigned*)(pp + C_DNK)); uv[j] = __builtin_nontemporal_load((const unsigned*)(pp + C_DNV));
      }
    }
    float2 cwq[4], cwk[4], cwv[4];
#pragma unroll
    for (int j = 0; j < 4; ++j) {
      cwq[j] = *(const float2*)(p.conv_w + j * 1536 + h * 128 + 2 * lane);
      cwk[j] = *(const float2*)(p.conv_w + j * 1536 + 512 + h * 128 + 2 * lane);
      cwv[j] = *(const float2*)(p.conv_w + j * 1536 + 1024 + h * 128 + 2 * lane);
    }
    asm volatile("" ::: "memory");
    float yqx[16], yqy[16], ykx[16], yky[16], sq[16], sk[16];
#pragma unroll
    for (int tt = 0; tt < 16; ++tt) {
      float ax = 0.f, ay = 0.f, bx = 0.f, by = 0.f, cx = 0.f, cy = 0.f;
#pragma unroll
      for (int j = 0; j < 4; ++j) {
        ax += cwq[j].x * bflo(uq[tt + j]); ay += cwq[j].y * bfhi(uq[tt + j]);
        bx += cwk[j].x * bflo(uk[tt + j]); by += cwk[j].y * bfhi(uk[tt + j]);
        cx += cwv[j].x * bflo(uv[tt + j]); cy += cwv[j].y * bfhi(uv[tt + j]);
      }
      ax = silu_f(ax); ay = silu_f(ay); bx = silu_f(bx); by = silu_f(by); cx = silu_f(cx); cy = silu_f(cy);
      yqx[tt] = ax; yqy[tt] = ay; ykx[tt] = bx; yky[tt] = by;
      sq[tt] = ax * ax + ay * ay; sk[tt] = bx * bx + by * by;
      *(unsigned*)(vb + (t0 + tt) * 128 + 2 * lane) = cvtpk(cx, cy);
    }
#define RED_STEP(X) { _Pragma("unroll") for (int tt = 0; tt < 16; ++tt) { sq[tt] += lx<X>(sq[tt]); sk[tt] += lx<X>(sk[tt]); } }
    RED_STEP(1) RED_STEP(2) RED_STEP(4) RED_STEP(8) RED_STEP(16)
#pragma unroll
    for (int tt = 0; tt < 16; ++tt) {
      const float rq = rsqrtf(lx32_sum(sq[tt]) + EPSV) * 0.08838834764831845f;
      const float rk = rsqrtf(lx32_sum(sk[tt]) + EPSV);
      *(unsigned*)(qn + (t0 + tt) * 136 + 2 * lane) = cvtpk(yqx[tt] * rq, yqy[tt] * rq);
      *(unsigned*)(kn + (t0 + tt) * 136 + 2 * lane) = cvtpk(ykx[tt] * rk, yky[tt] * rk);
    }
  }
  __syncthreads();
  {
    f32x4 akk[4], aqk[4];
#pragma unroll
    for (int i = 0; i < 4; ++i) { akk[i] = f32x4{0.f, 0.f, 0.f, 0.f}; aqk[i] = f32x4{0.f, 0.f, 0.f, 0.f}; }
#pragma unroll
    for (int ks = 0; ks < 4; ++ks) {
      const bf16x8 ak = *(const bf16x8*)((const char*)kn + (16 * wave + fr) * 272 + (32 * ks + 8 * fq) * 2);
      const bf16x8 aq = *(const bf16x8*)((const char*)qn + (16 * wave + fr) * 272 + (32 * ks + 8 * fq) * 2);
#pragma unroll
      for (int nt = 0; nt < 4; ++nt) {
        if (nt <= wave) {
          const bf16x8 bk = *(const bf16x8*)((const char*)kn + (16 * nt + fr) * 272 + (32 * ks + 8 * fq) * 2);
          akk[nt] = MFMA16(ak, bk, akk[nt]);
          aqk[nt] = MFMA16(aq, bk, aqk[nt]);
        }
      }
    }
#pragma unroll
    for (int nt = 0; nt < 4; ++nt)
#pragma unroll
      for (int j = 0; j < 4; ++j) {
        const int c = 16 * wave + 4 * fq + j, s = 16 * nt + fr;
        const float dec = (s <= c) ? __expf(gcs[c] - gcs[s]) : 0.f;
        const float mv = (s < c) ? bts[c] * akk[nt][j] * dec : 0.f;
        Mb[c * 64 + s] = f2bf(-mv);
        if (nt == wave) Md[wave * 256 + (c & 15) * 16 + (s & 15)] = mv;
        Asm[c * 64 + s] = f2bf((s <= c) ? aqk[nt][j] * dec : 0.f);
      }
    {
      const float* md = Md + wave * 256;
      float t[16];
#pragma unroll
      for (int i = 0; i < 16; ++i) t[i] = (i == lane) ? 1.f : 0.f;
#pragma unroll
      for (int j = 0; j < 15; ++j)
#pragma unroll
        for (int i = j + 1; i < 16; ++i) t[i] -= md[i * 16 + j] * t[j];
      if (lane < 16) {
#pragma unroll
        for (int i = 0; i < 16; ++i) Dv[wave * 256 + i * 16 + lane] = f2bf(t[i]);
      }
    }
  }
  __syncthreads();
  {
    const float glast = gcs[63];
#pragma unroll
    for (int it = 0; it < 4; ++it) {
      const int pp = tid + 256 * it;
      const int frag = pp >> 6, l2 = pp & 63, m = l2 & 15, qq = l2 >> 4;
      {
        const int mt = frag >> 2, ks = frag & 3, row = 16 * mt + m;
        const uint2 lo = *(const uint2*)((const char*)qn + row * 272 + (32 * ks + 4 * qq) * 2);
        const uint2 hi = *(const uint2*)((const char*)qn + row * 272 + (32 * ks + 16 + 4 * qq) * 2);
        const float e = egs[row];
        uint4 o;
        o.x = cvtpk(bflo(lo.x) * e, bfhi(lo.x) * e); o.y = cvtpk(bflo(lo.y) * e, bfhi(lo.y) * e);
        o.z = cvtpk(bflo(hi.x) * e, bfhi(hi.x) * e); o.w = cvtpk(bflo(hi.y) * e, bfhi(hi.y) * e);
        *(uint4*)(dnb + DN_QG + (size_t)pp * 16) = o;
      }
      {
        const int mtk = frag >> 1, ks = frag & 1, dk = 16 * mtk + m;
        float v[8];
#pragma unroll
        for (int j = 0; j < 8; ++j) {
          const int c = 32 * ks + ((j >> 2) << 4) + 4 * qq + (j & 3);
          v[j] = bf2f(kn[c * 136 + dk]) * kds[c];
        }
        uint4 o; o.x = cvtpk(v[0], v[1]); o.y = cvtpk(v[2], v[3]); o.z = cvtpk(v[4], v[5]); o.w = cvtpk(v[6], v[7]);
        *(uint4*)(dnb + DN_KD + (size_t)pp * 16) = o;
      }
      if (it < 2) {
        const int mt = frag >> 1, ks = frag & 1, row = 16 * mt + m;
        const uint2 lo = *(const uint2*)((const char*)Asm + row * 128 + (32 * ks + 4 * qq) * 2);
        const uint2 hi = *(const uint2*)((const char*)Asm + row * 128 + (32 * ks + 16 + 4 * qq) * 2);
        *(uint4*)(dnb + DN_A + (size_t)pp * 16) = make_uint4(lo.x, lo.y, hi.x, hi.y);
      }
    }
  }
  const bool isv = wave < 2;
  f32x4 Xs[4][4];
  {
    const f32x4 z4 = f32x4{0.f, 0.f, 0.f, 0.f};
    bf16x8 dinv[4], m10, m20, m30, m31;
#pragma unroll
    for (int I = 0; I < 4; ++I) {
      const uint2 lo = *(const uint2*)(Dv + I * 256 + fr * 16 + 4 * fq);
      dinv[I] = __builtin_bit_cast(bf16x8, make_uint4(lo.x, lo.y, 0u, 0u));
    }
#define MBFRAG(I_, P_) __builtin_bit_cast(bf16x8, make_uint4(((const uint2*)(Mb + (16 * (I_) + fr) * 64 + 32 * (P_) + 4 * fq))->x, ((const uint2*)(Mb + (16 * (I_) + fr) * 64 + 32 * (P_) + 4 * fq))->y, \
                                                              ((const uint2*)(Mb + (16 * (I_) + fr) * 64 + 32 * (P_) + 16 + 4 * fq))->x, ((const uint2*)(Mb + (16 * (I_) + fr) * 64 + 32 * (P_) + 16 + 4 * fq))->y))
    m10 = MBFRAG(1, 0); m20 = MBFRAG(2, 0); m30 = MBFRAG(3, 0); m31 = MBFRAG(3, 1);
#pragma unroll
    for (int nt = 0; nt < 4; ++nt) {
      const int colx = (64 * wave + 16 * nt + fr) & 127;
      const u16* srcp = isv ? (vb + colx) : (kn + colx);
      const int sst = isv ? 128 : 136;
      f32x4 R[4];
#pragma unroll
      for (int I = 0; I < 4; ++I)
#pragma unroll
        for (int j = 0; j < 4; ++j) {
          const int row = 16 * I + 4 * fq + j;
          R[I][j] = bf2f(srcp[row * sst]) * bts[row] * (isv ? 1.f : egs[row]);
        }
      const f32x4 X0 = MFMA16(dinv[0], pack8(R[0], z4), z4);
      const f32x4 Y1 = MFMA16(m10, pack8(X0, z4), R[1]);
      const f32x4 X1 = MFMA16(dinv[1], pack8(Y1, z4), z4);
      const bf16x8 x01 = pack8(X0, X1);
      const f32x4 Y2 = MFMA16(m20, x01, R[2]);
      const f32x4 X2 = MFMA16(dinv[2], pack8(Y2, z4), z4);
      f32x4 Y3 = MFMA16(m30, x01, R[3]);
      Y3 = MFMA16(m31, pack8(X2, z4), Y3);
      const f32x4 X3 = MFMA16(dinv[3], pack8(Y3, z4), z4);
      Xs[nt][0] = X0; Xs[nt][1] = X1; Xs[nt][2] = X2; Xs[nt][3] = X3;
    }
  }
  if (isv) {
#pragma unroll
    for (int nt = 0; nt < 4; ++nt)
#pragma unroll
      for (int I = 0; I < 4; ++I) {
        uint2 o; o.x = cvtpk(Xs[nt][I][0], Xs[nt][I][1]); o.y = cvtpk(Xs[nt][I][2], Xs[nt][I][3]);
        *(uint2*)(dnb + DN_U + (size_t)(((I * 8 + 4 * wave + nt) * 64 + lane) * 8)) = o;
      }
  }
  __syncthreads();
  if (!isv) {
#pragma unroll
    for (int nt = 0; nt < 4; ++nt) {
      const int colx = (64 * wave + 16 * nt + fr) & 127;
#pragma unroll
      for (int I = 0; I < 4; ++I)
#pragma unroll
        for (int j = 0; j < 4; ++j) qn[(16 * I + 4 * fq + j) * 136 + colx] = f2bf(-Xs[nt][I][j]);
    }
  }
  __syncthreads();
#pragma unroll
  for (int it = 0; it < 4; ++it) {
    const int pp = tid + 256 * it;
    const int frag = pp >> 6, l2 = pp & 63, m = l2 & 15, qq = l2 >> 4;
    const int mt = frag >> 2, ks = frag & 3, row = 16 * mt + m;
    const uint2 lo = *(const uint2*)((const char*)qn + row * 272 + (32 * ks + 4 * qq) * 2);
    const uint2 hi = *(const uint2*)((const char*)qn + row * 272 + (32 * ks + 16 + 4 * qq) * 2);
    *(uint4*)(dnb + DN_NEGW + (size_t)pp * 16) = make_uint4(lo.x, lo.y, hi.x, hi.y);
  }
  __syncthreads();
}

constexpr size_t OUT_SN = 0;
constexpr size_t OUT_VN = 33554432;
DI void p3_scan(const Params& p, int bh, char* smem, int wv) {
  int tid_ = (wv << 6) | lane_id(); asm volatile("" : "+v"(tid_)); const int tid = tid_, wave = tid >> 6, lane = tid & 63;
  f32x4 S[8][2]; bf16x8 Sb[4][2];
#pragma unroll
  for (int i = 0; i < 8; ++i) { S[i][0] = f32x4{0.f, 0.f, 0.f, 0.f}; S[i][1] = f32x4{0.f, 0.f, 0.f, 0.f}; }
#pragma unroll
  for (int i = 0; i < 4; ++i) { Sb[i][0] = bf16x8{0, 0, 0, 0, 0, 0, 0, 0}; Sb[i][1] = bf16x8{0, 0, 0, 0, 0, 0, 0, 0}; }
  char* L = smem;
  float* egl_s = (float*)(smem + 65536);
  const unsigned char* dn0 = p.ws + OFF_DN + (size_t)(bh * 32) * DN_CHUNK_B;
  unsigned char* sn0 = (unsigned char*)p.out + OUT_SN + (size_t)(bh * 32) * 32768;
  unsigned char* vn0 = (unsigned char*)p.out + OUT_VN + (size_t)(bh * 32) * 16384;
  if (tid < 32) egl_s[tid] = __expf(((const float*)(p.ws + OFF_GLAST))[bh * 32 + tid]);
  uint4 r0, r1, r2, r3, r4, r5, r6, r7; uint2 un[8];
#define SC_NT4(p_) __builtin_bit_cast(uint4, __builtin_nontemporal_load((const f32x4*)(p_)))
#define SC_LOADC(n_) { const uint4* a_ = (const uint4*)(dn0 + (size_t)(n_) * DN_CHUNK_B + DN_NEGW) + tid; \
                       const uint4* b_ = (const uint4*)(dn0 + (size_t)(n_) * DN_CHUNK_B + DN_KD) + tid; \
                       r0 = SC_NT4(a_); r1 = SC_NT4(a_ + 256); r2 = SC_NT4(a_ + 512); r3 = SC_NT4(a_ + 768); \
                       r4 = SC_NT4(b_); r5 = SC_NT4(b_ + 256); r6 = SC_NT4(b_ + 512); r7 = SC_NT4(b_ + 768); }
#define SC_LOADU(dst, n_) { const uint2* u_ = (const uint2*)(dn0 + (size_t)(n_) * DN_CHUNK_B + DN_U) + lane; \
                            dst[0] = u_[(0 + 2 * wave) * 64]; dst[1] = u_[(0 + 2 * wave + 1) * 64]; dst[2] = u_[(8 + 2 * wave) * 64]; dst[3] = u_[(8 + 2 * wave + 1) * 64]; \
                            dst[4] = u_[(16 + 2 * wave) * 64]; dst[5] = u_[(16 + 2 * wave + 1) * 64]; dst[6] = u_[(24 + 2 * wave) * 64]; dst[7] = u_[(24 + 2 * wave + 1) * 64]; }
#define SC_STOREL(buf) { uint4* l_ = (uint4*)(L + (buf) * 32768) + tid; \
                         l_[0] = r0; l_[256] = r1; l_[512] = r2; l_[768] = r3; l_[1024] = r4; l_[1280] = r5; l_[1536] = r6; l_[1792] = r7; }
  unsigned warm = 0u;
  const unsigned char* tbase = dn0 + (wv & 1) * 8192 + (wv >> 1) * 32768;
  const unsigned char* ubase = dn0 + DN_U + (wv & 1) * 8192;
#define SC_TOUCH(n_) { const unsigned toff_ = (unsigned)lane * 128u; \
    asm volatile("global_load_dword %0, %1, %2" : "+v"(warm) : "v"(toff_), "s"(tbase + (size_t)(n_) * DN_CHUNK_B) : "memory"); \
    asm volatile("global_load_dword %0, %1, %2" : "+v"(warm) : "v"(toff_), "s"(ubase + (size_t)(n_) * DN_CHUNK_B) : "memory"); }
  SC_TOUCH(2); SC_TOUCH(3); SC_TOUCH(4);
  SC_LOADC(0); SC_LOADU(un, 0); SC_STOREL(0);
  __syncthreads();
  SC_LOADC(1);
  for (int n = 0; n < 32; ++n) {
    const char* B = L + (n & 1) * 32768 + lane * 16;
    if (n + 5 < 32) SC_TOUCH(n + 5);
    f32x4 av[4][2];
#pragma unroll
    for (int mt = 0; mt < 4; ++mt)
#pragma unroll
      for (int nt = 0; nt < 2; ++nt) { const uint2 u2 = un[mt * 2 + nt]; av[mt][nt] = f32x4{bflo(u2.x), bfhi(u2.x), bflo(u2.y), bfhi(u2.y)}; }
    if (n + 1 < 32) SC_LOADU(un, n + 1);
#pragma unroll
    for (int mt = 0; mt < 4; ++mt)
#pragma unroll
      for (int ks = 0; ks < 4; ++ks) {
        const bf16x8 af = *(const bf16x8*)(B + (mt * 4 + ks) * 1024);
        av[mt][0] = MFMA16(af, Sb[ks][0], av[mt][0]);
        av[mt][1] = MFMA16(af, Sb[ks][1], av[mt][1]);
      }
    bf16x8 vbf[2][2];
#pragma unroll
    for (int k2 = 0; k2 < 2; ++k2)
#pragma unroll
      for (int nt = 0; nt < 2; ++nt) vbf[k2][nt] = pack8(av[2 * k2][nt], av[2 * k2 + 1][nt]);
    {
      unsigned char* sn = sn0 + (size_t)n * 32768 + lane * 16;
      unsigned char* vn = vn0 + (size_t)n * 16384 + lane * 16;
#pragma unroll
      for (int ks = 0; ks < 4; ++ks)
#pragma unroll
        for (int nt = 0; nt < 2; ++nt) *(bf16x8*)(sn + (ks * 8 + 2 * wave + nt) * 1024) = Sb[ks][nt];
#pragma unroll
      for (int k2 = 0; k2 < 2; ++k2)
#pragma unroll
        for (int nt = 0; nt < 2; ++nt) *(bf16x8*)(vn + (k2 * 8 + 2 * wave + nt) * 1024) = vbf[k2][nt];
    }
    const float egl = egl_s[n];
#pragma unroll
    for (int mk = 0; mk < 8; ++mk) {
#pragma unroll
      for (int nt = 0; nt < 2; ++nt) { S[mk][nt][0] *= egl; S[mk][nt][1] *= egl; S[mk][nt][2] *= egl; S[mk][nt][3] *= egl; }
#pragma unroll
      for (int k2 = 0; k2 < 2; ++k2) {
        const bf16x8 af = *(const bf16x8*)(B + 16384 + (mk * 2 + k2) * 1024);
        S[mk][0] = MFMA16(af, vbf[k2][0], S[mk][0]);
        S[mk][1] = MFMA16(af, vbf[k2][1], S[mk][1]);
      }
    }
#pragma unroll
    for (int ks = 0; ks < 4; ++ks)
#pragma unroll
      for (int nt = 0; nt < 2; ++nt) Sb[ks][nt] = pack8(S[2 * ks][nt], S[2 * ks + 1][nt]);
    if (n + 1 < 32) SC_STOREL((n + 1) & 1);
    if (n + 2 < 32) SC_LOADC(n + 2);
    __syncthreads();
  }
  asm volatile("s_waitcnt vmcnt(0)" ::: "memory");
  asm volatile("" :: "v"(warm));
  __syncthreads();
  if (tid == 0) {
    __builtin_amdgcn_fence(__ATOMIC_RELEASE, "agent");
    asm volatile("s_waitcnt vmcnt(0)" ::: "memory");
    __hip_atomic_store((unsigned*)(p.ws + OFF_CTR) + 128 + bh, 1u, __ATOMIC_RELAXED, __HIP_MEMORY_SCOPE_AGENT);
  }
}

DI void p4_dnout(const Params& p, int ci, char* smem, int wv) {
  int tid_ = (wv << 6) | lane_id(); asm volatile("" : "+v"(tid_)); const int tid = tid_, wave = tid >> 6, lane = tid & 63, fr = lane & 15, fq = lane >> 4;
  const int n = ci & 31, h = (ci >> 5) & 3, b = ci >> 7;
  float* rd = (float*)smem;
  const unsigned char* base = p.ws + OFF_DN + (size_t)ci * DN_CHUNK_B;
  const uint4* qg = (const uint4*)(base + DN_QG) + lane;
  const uint4* aa = (const uint4*)(base + DN_A) + lane;
  const unsigned char* sn = (const unsigned char*)p.out + OUT_SN + (size_t)ci * 32768 + lane * 16;
  const unsigned char* vn = (const unsigned char*)p.out + OUT_VN + (size_t)ci * 16384 + lane * 16;
  bf16x8 Sb[4][2], vbf[2][2];
#pragma unroll
  for (int ks = 0; ks < 4; ++ks)
#pragma unroll
    for (int nt = 0; nt < 2; ++nt) Sb[ks][nt] = *(const bf16x8*)(sn + (ks * 8 + 2 * wave + nt) * 1024);
#pragma unroll
  for (int k2 = 0; k2 < 2; ++k2)
#pragma unroll
    for (int nt = 0; nt < 2; ++nt) vbf[k2][nt] = *(const bf16x8*)(vn + (k2 * 8 + 2 * wave + nt) * 1024);
  f32x4 ao[4][2];
#pragma unroll
  for (int mt = 0; mt < 4; ++mt) {
    ao[mt][0] = f32x4{0.f, 0.f, 0.f, 0.f}; ao[mt][1] = f32x4{0.f, 0.f, 0.f, 0.f};
#pragma unroll
    for (int ks = 0; ks < 4; ++ks) {
      const bf16x8 af = __builtin_bit_cast(bf16x8, qg[(mt * 4 + ks) * 64]);
      ao[mt][0] = MFMA16(af, Sb[ks][0], ao[mt][0]);
      ao[mt][1] = MFMA16(af, Sb[ks][1], ao[mt][1]);
    }
#pragma unroll
    for (int k2 = 0; k2 < 2; ++k2) {
      const bf16x8 af = __builtin_bit_cast(bf16x8, aa[(mt * 2 + k2) * 64]);
      ao[mt][0] = MFMA16(af, vbf[k2][0], ao[mt][0]);
      ao[mt][1] = MFMA16(af, vbf[k2][1], ao[mt][1]);
    }
  }
  float gn[2];
  gn[0] = p.dn_out_gain[32 * wave + fr]; gn[1] = p.dn_out_gain[32 * wave + 16 + fr];
  const u16* proj = (const u16*)(p.ws + OFF_PROJ);
  u16* mixed = (u16*)(p.ws + OFF_HB);
#pragma unroll
  for (int mt = 0; mt < 4; ++mt)
#pragma unroll
    for (int j = 0; j < 4; ++j) {
      float s = ao[mt][0][j] * ao[mt][0][j] + ao[mt][1][j] * ao[mt][1][j];
      s += lx<1>(s); s += lx<2>(s); s += lx<4>(s); s += lx<8>(s);
      if (fr == 0) rd[wave * 64 + 16 * mt + 4 * fq + j] = s;
    }
  __syncthreads();
#pragma unroll
  for (int mt = 0; mt < 4; ++mt)
#pragma unroll
    for (int j = 0; j < 4; ++j) {
      const int c = 16 * mt + 4 * fq + j;
      const float tot = rd[c] + rd[64 + c] + rd[128 + c] + rd[192 + c];
      const float rstd = rsqrtf(tot * (1.f / 128.f) + EPSV);
      const size_t tok = (size_t)b * SEQ + n * 64 + c;
#pragma unroll
      for (int nt = 0; nt < 2; ++nt) {
        const int dv = 32 * wave + 16 * nt + fr;
        const float z = bf2f(proj[tok * NP + C_DNZ + h * 128 + dv]);
        mixed[tok * 1024 + h * 128 + dv] = f2bf(ao[mt][nt][j] * rstd * gn[nt] * silu_f(z));
      }
    }
  __syncthreads();
}

DI void p3_attn(const Params& p, int bh, int qb, char* smem, int wv) {
  int tid_ = (wv << 6) | lane_id(); asm volatile("" : "+v"(tid_)); const int tid = tid_, wave = tid >> 6, lane = tid & 63, fr = lane & 15, fq = lane >> 4;
  const int b = bh >> 2, h = bh & 3;
  char* Ks = smem; char* Vs = smem + 32768;
  const u16* proj = (const u16*)(p.ws + OFF_PROJ);
  const size_t tokb = (size_t)b * SEQ;
  const int qrow = qb * 64 + 16 * wave + fr;
  bf16x8 qf[2][2];
#pragma unroll
  for (int mp = 0; mp < 2; ++mp)
#pragma unroll
    for (int ks = 0; ks < 2; ++ks) qf[mp][ks] = __builtin_bit_cast(bf16x8, __builtin_nontemporal_load((const f32x4*)(proj + (tokb + qrow) * NP + C_DFQ + h * 128 + mp * 64 + 32 * ks + 8 * fq)));
  f32x4 O[2][8];
#pragma unroll
  for (int mp = 0; mp < 2; ++mp)
#pragma unroll
    for (int i = 0; i < 8; ++i) O[mp][i] = f32x4{0.f, 0.f, 0.f, 0.f};
  float mrun[2] = {-INFINITY, -INFINITY}, lrun[2] = {0.f, 0.f};
  const int ntiles = qb + 1;
  const int srow = tid >> 4, c16 = tid & 15;
  const int koff = srow * 256 + ((c16 ^ (srow & 15)) << 4);
  const int voff = srow * 256 + (((c16 >> 1) ^ (srow & 7)) << 5) + ((c16 & 1) << 4);
  const u16* kg = proj + (tokb + srow) * NP + C_DFK + h * 128 + c16 * 8;
  const u16* vg = proj + (tokb + srow) * NP + C_DFV + h * 128 + c16 * 8;
  uint4 rk[4], rv[4];
#pragma unroll
  for (int i = 0; i < 4; ++i) { rk[i] = *(const uint4*)(kg + (size_t)(16 * i) * NP); rv[i] = *(const uint4*)(vg + (size_t)(16 * i) * NP); }
#pragma unroll
  for (int i = 0; i < 4; ++i) { *(uint4*)(Ks + koff + i * 4096) = rk[i]; *(uint4*)(Vs + voff + i * 4096) = rv[i]; }
  __syncthreads();
  const int trr = fr >> 2, trp = fr & 3;
  for (int kt = 0; kt < ntiles; ++kt) {
    const int buf = (kt & 1) * 16384;
    if (kt + 1 < ntiles) {
#pragma unroll
      for (int i = 0; i < 4; ++i) {
        rk[i] = *(const uint4*)(kg + (size_t)((kt + 1) * 64 + 16 * i) * NP);
        rv[i] = *(const uint4*)(vg + (size_t)((kt + 1) * 64 + 16 * i) * NP);
      }
    }
    f32x4 st[2][4];
#pragma unroll
    for (int mp = 0; mp < 2; ++mp)
#pragma unroll
      for (int mt = 0; mt < 4; ++mt) {
        st[mp][mt] = f32x4{0.f, 0.f, 0.f, 0.f};
#pragma unroll
        for (int ks = 0; ks < 2; ++ks) {
          const bf16x8 ka = *(const bf16x8*)(Ks + buf + (16 * mt + fr) * 256 + (((mp * 8 + ks * 4 + fq) ^ fr) << 4));
          st[mp][mt] = MFMA16(ka, qf[mp][ks], st[mp][mt]);
        }
      }
    if (kt == qb) {
#pragma unroll
      for (int mt = 0; mt < 4; ++mt)
#pragma unroll
        for (int j = 0; j < 4; ++j) {
          const int key = kt * 64 + 16 * mt + 4 * fq + j;
          if (key > qrow) { st[0][mt][j] = -INFINITY; st[1][mt][j] = -INFINITY; }
        }
    }
    bf16x8 pf[2][2];
#pragma unroll
    for (int mp = 0; mp < 2; ++mp) {
      float mx = st[mp][0][0];
#pragma unroll
      for (int mt = 0; mt < 4; ++mt)
#pragma unroll
        for (int j = 0; j < 4; ++j) mx = fmaxf(mx, st[mp][mt][j]);
      if (__builtin_amdgcn_ballot_w64(mx > mrun[mp] + 8.f) != 0ull) {
        mx = fmaxf(mx, lx<16>(mx)); mx = lx32_max(mx);
        const float mnew = fmaxf(mrun[mp], mx);
        const float alpha = __builtin_amdgcn_exp2f(mrun[mp] - mnew);
        mrun[mp] = mnew;
        lrun[mp] *= alpha;
#pragma unroll
        for (int i = 0; i < 8; ++i) { O[mp][i][0] *= alpha; O[mp][i][1] *= alpha; O[mp][i][2] *= alpha; O[mp][i][3] *= alpha; }
      }
      const float mref = mrun[mp];
      float ps = 0.f;
#pragma unroll
      for (int mt = 0; mt < 4; ++mt)
#pragma unroll
        for (int j = 0; j < 4; ++j) { const float e = __builtin_amdgcn_exp2f(st[mp][mt][j] - mref); st[mp][mt][j] = e; ps += e; }
      lrun[mp] += ps;
      pf[mp][0] = pack8(st[mp][0], st[mp][1]);
      pf[mp][1] = pack8(st[mp][2], st[mp][3]);
    }
#pragma unroll
    for (int k2 = 0; k2 < 2; ++k2) {
      const int r0 = 32 * k2 + 4 * fq + trr, r1 = r0 + 16;
#pragma unroll
      for (int mv = 0; mv < 8; ++mv) {
        const s16x4 lo = vtr(Vs + buf + r0 * 256 + ((mv ^ (r0 & 7)) << 5) + 8 * trp);
        const s16x4 hi = vtr(Vs + buf + r1 * 256 + ((mv ^ (r1 & 7)) << 5) + 8 * trp);
        const bf16x8 va = __builtin_shufflevector(lo, hi, 0, 1, 2, 3, 4, 5, 6, 7);
        O[0][mv] = MFMA16(va, pf[0][k2], O[0][mv]);
        O[1][mv] = MFMA16(va, pf[1][k2], O[1][mv]);
      }
    }
    if (kt + 1 < ntiles) {
      const int nb = ((kt + 1) & 1) * 16384;
#pragma unroll
      for (int i = 0; i < 4; ++i) { *(uint4*)(Ks + nb + koff + i * 4096) = rk[i]; *(uint4*)(Vs + nb + voff + i * 4096) = rv[i]; }
    }
    __syncthreads();
  }
  int tid2 = (wv << 6) | lane_id(); asm volatile("" : "+v"(tid2));
  const int qrow_e = qb * 64 + 16 * (tid2 >> 6) + (tid2 & 15), fq_e = (tid2 >> 4) & 3;
  float inv[2];
#pragma unroll
  for (int mp = 0; mp < 2; ++mp) { float l = lrun[mp]; l += lx<16>(l); l = lx32_sum(l); inv[mp] = 1.f / l; }
  const float li = *(const float*)(smem + 73744) * inv[1];
  float ss = 0.f;
#pragma unroll
  for (int mv = 0; mv < 8; ++mv)
#pragma unroll
    for (int j = 0; j < 4; ++j) { const float o = O[0][mv][j] * inv[0] - li * O[1][mv][j]; O[0][mv][j] = o; ss += o * o; }
  ss += lx<16>(ss); ss = lx32_sum(ss);
  const float rstd = rsqrtf(ss * (1.f / 128.f) + EPSV) * 0.8f;
  u16* mixed = (u16*)(p.ws + OFF_HB);
#pragma unroll
  for (int mv = 0; mv < 8; ++mv) {
    const int dv = 16 * mv + 4 * fq_e;
    typedef unsigned u32x2 __attribute__((ext_vector_type(2)));
    const u32x2 zz_ = __builtin_nontemporal_load((const u32x2*)(proj + (tokb + qrow_e) * NP + C_DFZ + h * 128 + dv));
    const uint2 zz = make_uint2(zz_[0], zz_[1]);
    const float4 g4 = *(const float4*)(p.df_out_gain + dv);
    uint2 o;
    o.x = cvtpk(O[0][mv][0] * rstd * g4.x * silu_f(bflo(zz.x)), O[0][mv][1] * rstd * g4.y * silu_f(bfhi(zz.x)));
    o.y = cvtpk(O[0][mv][2] * rstd * g4.z * silu_f(bflo(zz.y)), O[0][mv][3] * rstd * g4.w * silu_f(bfhi(zz.y)));
    *(uint2*)(mixed + (tokb + qrow_e) * 1024 + 512 + h * 128 + dv) = o;
  }
}

#define XB_TMO      128
#define XB_XCNT(j)  (256  + 64 * (j))
#define XB_XSUB(j)  (1280 + 64 * (j))
#define XB_XGEN(j)  (2304 + 64 * (j))
#define XB_TOP      3328
#define XB_TOPGEN   3392
#define XCD_BAR_WORDS 3456
#define XB_SPIN_CAP (1u << 18)
#define LAS __attribute__((address_space(3)))
DI unsigned xb_ld(unsigned* p) { return __hip_atomic_load(p, __ATOMIC_RELAXED, __HIP_MEMORY_SCOPE_AGENT); }
DI unsigned xb_add(unsigned* p, unsigned v) { return __hip_atomic_fetch_add(p, v, __ATOMIC_RELAXED, __HIP_MEMORY_SCOPE_AGENT); }
DI unsigned xb_xcc_id() { return (unsigned)__builtin_amdgcn_s_getreg((3 << 11) | 20) & 0xFu; }
#define XB_SPIN(cond, bar) do { unsigned _sp = 0; while (cond) { __builtin_amdgcn_s_sleep(1); \
    if ((++_sp & 255u) == 0u) { if (xb_ld(&(bar)[XB_TMO])) break; if (_sp > XB_SPIN_CAP) { atomicAdd(&(bar)[XB_TMO], 1u); break; } } } } while (0)
DI void xcd_barrier_complete(unsigned* bar, unsigned x, unsigned& nloc, unsigned& nx) {
  const unsigned G = gridDim.x;
  unsigned sum, cnt, mine, sp = 0u;
  for (;;) {
    sum = 0u; cnt = 0u; mine = 0u;
#pragma unroll
    for (unsigned j = 0; j < 16; ++j) { const unsigned c = xb_ld(&bar[XB_XCNT(j)]); sum += c; cnt += (c > 0u) ? 1u : 0u; mine = (j == x) ? c : mine; }
    if (sum == G) break;
    __builtin_amdgcn_s_sleep(1);
    if ((++sp & 255u) == 0u) { if (xb_ld(&bar[XB_TMO])) break; if (sp > XB_SPIN_CAP) { atomicAdd(&bar[XB_TMO], 1u); break; } }
  }
  nloc = mine > 0u ? mine : 1u; nx = cnt > 0u ? cnt : 1u;
}
DI void xcd_barrier(unsigned* bar, volatile LAS unsigned* st, bool leader) {
  asm volatile("s_waitcnt vmcnt(0)" ::: "memory");
  __syncthreads();
  if (leader) {
    const unsigned x = xb_xcc_id();
    __builtin_amdgcn_s_waitcnt(0);
    unsigned nloc = st[0], nx = st[1];
    if (nloc == 0u) { xcd_barrier_complete(bar, x, nloc, nx); st[0] = nloc; st[1] = nx; }
    const unsigned old = xb_add(&bar[XB_XSUB(x)], 1u);
    const unsigned gen = old / nloc;
    if (old + 1u == (gen + 1u) * nloc) {
      __builtin_amdgcn_fence(__ATOMIC_RELEASE, "agent");
      asm volatile("s_waitcnt vmcnt(0)" ::: "memory");
      const unsigned og = xb_add(&bar[XB_TOP], 1u);
      const unsigned tg = og / nx;
      if (og + 1u == (tg + 1u) * nx) xb_add(&bar[XB_TOPGEN], 1u);
      else XB_SPIN(xb_ld(&bar[XB_TOPGEN]) == tg, bar);
      __builtin_amdgcn_fence(__ATOMIC_ACQUIRE, "agent");
      xb_add(&bar[XB_XGEN(x)], 1u);
      asm volatile("s_waitcnt vmcnt(0)" ::: "memory");
    } else {
      XB_SPIN(xb_ld(&bar[XB_XGEN(x)]) == gen, bar);
      __builtin_amdgcn_fence(__ATOMIC_ACQUIRE, "agent");
      asm volatile("s_waitcnt vmcnt(0)" ::: "memory");
    }
  }
  __syncthreads();
}

template <int ONLY>
__global__ void __launch_bounds__(256, 2) fwd_kernel(Params p) {
  __shared__ __attribute__((aligned(16))) char smem[SMEM_BYTES];
  const int nb = gridDim.x, bid = blockIdx.x;
  const int wv = __builtin_amdgcn_readfirstlane((int)(threadIdx.x >> 6));
  __shared__ uint4 xb_words;
  unsigned* const gbar = (unsigned*)(p.ws + OFF_BAR);
  volatile LAS unsigned* const xst = (volatile LAS unsigned*)&xb_words;
  if (ONLY < 0) {
    if (wv == 0 && lane_id() == 0) { xb_words = make_uint4(0u, 0u, 0u, 0u); (void)xb_add(&gbar[XB_XCNT(xb_xcc_id())], 1u); }
    __syncthreads();
    if (p.coop == 2) cg::this_grid().sync();
  }
#define GRID_SYNC() xcd_barrier(gbar, xst, wv == 0 && lane_id() == 0)
  if (ONLY < 0 || ONLY == 0) {
    if (bid == 0 && wv < 3) ((unsigned*)(p.ws + OFF_CTR))[(wv << 6) | lane_id()] = 0u;
    for (int it = bid; it < 1024 + 256; it += nb) {
      if (it < 1024) p0_transpose(p.w_in, WIN_LD, true, (u16*)(p.ws + OFF_WTIN), it & 15, it >> 4, smem, wv);
      else { const int t = it - 1024; p0_transpose(p.w_out, 1024, false, (u16*)(p.ws + OFF_WTOUT), t & 15, t >> 4, smem, wv); }
    }
    p0_fill_w8(p, smem, wv);
    __syncthreads();
    for (int it = bid; it < 4096; it += nb) p0_rows(p, it, smem, wv);
    __syncthreads();
  }
  if (ONLY < 0) GRID_SYNC();
  if (ONLY < 0 || ONLY == 1) {
    for (int rep = 0; rep < REP_G1; ++rep)
    for (int it = bid; it < 4096; it += nb)
      gemm_tile<1>(p, (const u16*)(p.ws + OFF_HB), (const u16*)(p.ws + OFF_WTIN), (it >> 5) * 128, (it & 31) * 128, smem, wv);
  }
  if (ONLY < 0) GRID_SYNC();
  if (ONLY < 0 || ONLY == 2) {
    for (int l = bid >> 3; l < 128; l += (nb >> 3)) p2_prep(p, (bid & 7) * 128 + l, smem, wv);
#if REP_PREP > 1
    for (int it = bid; it < 1024; it += nb) p2_prep(p, it, smem, wv);
#endif
  }
  if (ONLY < 0) GRID_SYNC();
  if (ONLY < 0 || ONLY == 3) {
    const int lane = lane_id();
    const float s1 = wave_sum(p.lq1[lane] * p.lk1[lane]), s2 = wave_sum(p.lq2[lane] * p.lk2[lane]);
    if (wv == 0 && lane == 0) *(float*)(smem + 73744) = __expf(s1) - __expf(s2) + 0.2f;
    __syncthreads();
    if (bid < 32) p3_scan(p, (bid & 7) * 4 + (bid >> 3), smem, wv);
    int* slot = (int*)(smem + 73728);
    const int xcc = bid & 7;
    for (int qi = 0; qi < 8; ++qi) {
      const int qx = (xcc + qi) & 7;
      unsigned* ctr = (unsigned*)(p.ws + OFF_CTR) + qx * 16;
      while (true) {
        if (wv == 0 && lane == 0) *slot = (int)atomicAdd(ctr, 1u);
        __syncthreads();
        const int it = *slot;
        __syncthreads();
        if (it >= 256) break;
        if (it < 128) {
          p3_attn(p, qx * 4 + (it & 3), 31 - (it >> 2), smem, wv);
        } else {
          const int bh = qx * 4 + (it & 3);
          if (wv == 0 && lane == 0) {
            unsigned* fl = (unsigned*)(p.ws + OFF_CTR) + 128 + bh;
            while (__hip_atomic_load(fl, __ATOMIC_RELAXED, __HIP_MEMORY_SCOPE_AGENT) == 0u) __builtin_amdgcn_s_sleep(2);
            __builtin_amdgcn_fence(__ATOMIC_ACQUIRE, "agent");
            asm volatile("s_waitcnt vmcnt(0)" ::: "memory");
          }
          __syncthreads();
          p4_dnout(p, bh * 32 + ((it - 128) >> 2), smem, wv);
        }
      }
    }
  }
  if (ONLY < 0) GRID_SYNC();
  if (ONLY < 0 || ONLY == 5) {
    for (int it = bid; it < 1024; it += nb) {
      const int xq = it & 7, s = it >> 3;
      gemm_tile<2>(p, (const u16*)(p.ws + OFF_HB), (const u16*)(p.ws + OFF_WTOUT), (xq * 16 + (s >> 3)) * 128, (s & 7) * 128, smem, wv);
    }
  }
}

extern "C" void kernel_launch(void* const* d_in, const int* in_sizes, int n_in, void* d_out, int out_size, void* d_ws, size_t ws_size,
                              hipStream_t stream) {
  Params p{};
  p.x = (const float*)d_in[0]; p.norm_gain = (const float*)d_in[1]; p.w_in = (const float*)d_in[2]; p.conv_w = (const float*)d_in[3];
  p.a_log = (const float*)d_in[4]; p.dt_bias = (const float*)d_in[5]; p.dn_out_gain = (const float*)d_in[6]; p.q_gain = (const float*)d_in[7];
  p.k_gain = (const float*)d_in[8]; p.lq1 = (const float*)d_in[9]; p.lk1 = (const float*)d_in[10]; p.lq2 = (const float*)d_in[11];
  p.lk2 = (const float*)d_in[12]; p.df_out_gain = (const float*)d_in[13]; p.w_out = (const float*)d_in[14];
  p.out = (float*)d_out; p.ws = (unsigned char*)d_ws;
  static int grid_blocks = 0;
  if (!grid_blocks) {
    int dev = 0, cus = 0, per_cu = 0;
    (void)hipGetDevice(&dev);
    (void)hipDeviceGetAttribute(&cus, hipDeviceAttributeMultiprocessorCount, dev);
#if USE_COOP
    (void)hipOccupancyMaxActiveBlocksPerMultiprocessor(&per_cu, fwd_kernel<-1>, 256, 0);
#else
    per_cu = 2;
#endif
    if (per_cu > 2) per_cu = 2;
    if (per_cu < 1) per_cu = 1;
    grid_blocks = cus * per_cu;
  }
#if USE_COOP
  (void)hipMemsetAsync((unsigned char*)d_ws + OFF_BAR, 0, 3456 * 4, stream);
  p.phase_lo = 0; p.phase_hi = 5; p.coop = 1;
  void* args[] = {&p};
  hipError_t e = hipLaunchCooperativeKernel((void*)fwd_kernel<-1>, dim3(grid_blocks), dim3(256), args, 0, stream);
  if (e != hipSuccess) fprintf(stderr, "cooperative launch failed: %s (grid %d)\n", hipGetErrorString(e), grid_blocks);
#else
  p.coop = 0;
  p.phase_lo = 0; p.phase_hi = 1; hipLaunchKernelGGL(fwd_kernel<0>, dim3(grid_blocks), dim3(256), 0, stream, p);
  p.phase_lo = 1; p.phase_hi = 2; hipLaunchKernelGGL(fwd_kernel<1>, dim3(grid_blocks), dim3(256), 0, stream, p);
  p.phase_lo = 2; p.phase_hi = 3; hipLaunchKernelGGL(fwd_kernel<2>, dim3(grid_blocks), dim3(256), 0, stream, p);
  p.phase_lo = 3; p.phase_hi = 4; hipLaunchKernelGGL(fwd_kernel<3>, dim3(grid_blocks), dim3(256), 0, stream, p);
  p.phase_lo = 4; p.phase_hi = 5; hipLaunchKernelGGL(fwd_kernel<4>, dim3(grid_blocks), dim3(256), 0, stream, p);
  p.phase_lo = 5; p.phase_hi = 6; hipLaunchKernelGGL(fwd_kernel<5>, dim3(grid_blocks), dim3(256), 0, stream, p);
#endif
}
```
